# Optimizing an MI355X kernel written in HIP

```python
import math
import jax, jax.numpy as jnp
from jax import lax
import numpy as np

D_MODEL = 2048
BATCH = 4
SEQ = 2048
DEPTH = 1

CHUNK = 64
Q_BLOCK = 128
MIX_WIDTH = D_MODEL
POOL_WIDTH = MIX_WIDTH // 2
POOL_WINDOWS = (2, 4, 8, 16)
N_POOL_GROUPS = len(POOL_WINDOWS)
POOL_GROUP = POOL_WIDTH // N_POOL_GROUPS
ATTN_WIDTH = MIX_WIDTH - POOL_WIDTH
DIFF_HEAD_DIM = 64
N_DIFF_HEADS = ATTN_WIDTH // (2 * DIFF_HEAD_DIM)
QK_WIDTH = N_DIFF_HEADS * 2 * DIFF_HEAD_DIM
IN_WIDTH = POOL_WIDTH + 2 * QK_WIDTH + ATTN_WIDTH
ROPE_THETA = 10000.0
FFN_HIDDEN = int(math.ceil(8 * D_MODEL / 3 / 256) * 256)
NORM_EPS = 1e-6

kernel_name = "hybrid_pool_diffattn_block"


def rms_norm(x, g):
    xf = x.astype(jnp.float32)
    y = xf * lax.rsqrt(jnp.mean(xf * xf, axis=-1, keepdims=True) + NORM_EPS)
    return (y * g.astype(jnp.float32)).astype(x.dtype)


def rotary_tables(seq, dim):
    inv_freq = ROPE_THETA ** (-jnp.arange(0, dim, 2, dtype=jnp.float32) / dim)
    ang = jnp.arange(seq, dtype=jnp.float32)[:, None] * inv_freq[None, :]
    return jnp.cos(ang), jnp.sin(ang)


def apply_rotary(t, cos, sin):
    half = t.shape[-1] // 2
    t1, t2 = t[..., :half], t[..., half:]
    c = cos[None, :, None, None, :].astype(t.dtype)
    s = sin[None, :, None, None, :].astype(t.dtype)
    return jnp.concatenate([t1 * c - t2 * s, t1 * s + t2 * c], axis=-1)


def multiscale_pool(u, w_pool, pool_scale):
    B, S, _ = u.shape
    uf = u.astype(jnp.float32)
    cs = jnp.concatenate([jnp.zeros((B, 1, POOL_WIDTH), jnp.float32),
                          jnp.cumsum(uf, axis=1)], axis=1)
    pos = jnp.arange(S, dtype=jnp.int32)
    outs = []
    for gi, w in enumerate(POOL_WINDOWS):
        sl = slice(gi * POOL_GROUP, (gi + 1) * POOL_GROUP)
        csg = cs[:, :, sl]
        hi = csg[:, 1:]
        lo = jnp.concatenate([jnp.zeros((B, w - 1, POOL_GROUP), jnp.float32),
                              csg[:, :S - w + 1]], axis=1)
        cnt = jnp.minimum(pos + 1, w).astype(jnp.float32)[None, :, None]
        outs.append((hi - lo) / cnt - uf[:, :, sl])
    pooled = jnp.stack(outs, axis=2).astype(u.dtype)
    mapped = jnp.einsum('bsgc,gcd->bsgd', pooled, w_pool)
    return mapped.reshape(B, S, POOL_WIDTH) * pool_scale


def diff_attention(q, k, v, lam, lam_init, subln_gain):
    B, S = q.shape[0], q.shape[1]
    scale = 1.0 / math.sqrt(DIFF_HEAD_DIM)
    outs = []
    for i in range(S // Q_BLOCK):
        q0, kend = i * Q_BLOCK, (i + 1) * Q_BLOCK
        qb = q[:, q0:kend]
        kb = k[:, :kend]
        vb = v[:, :kend]
        s = jnp.einsum('bqhcd,bkhcd->bhcqk', qb, kb).astype(jnp.float32) * scale
        q_chunk = (q0 + jnp.arange(Q_BLOCK)) // CHUNK
        k_chunk = jnp.arange(kend) // CHUNK
        mask = q_chunk[:, None] >= k_chunk[None, :]
        s = jnp.where(mask[None, None, None], s, -jnp.inf)
        p = jax.nn.softmax(s, axis=-1)
        a = p[:, :, 0] - lam * p[:, :, 1]
        o = jnp.einsum('bhqk,bkhe->bqhe', a.astype(vb.dtype), vb)
        outs.append(o)
    o = jnp.concatenate(outs, axis=1)
    o = rms_norm(o, subln_gain) * (1.0 - lam_init)
    return o.reshape(B, S, ATTN_WIDTH)


def setup_inputs(seed: int = 0) -> dict:
    key = jax.random.key(seed)
    ks = jax.random.split(key, 16)
    f32 = jnp.float32
    nrm = lambda k, shape, s: (jax.random.normal(k, shape, f32) * s)
    L = DEPTH
    return {
        "x": jax.random.normal(ks[0], (BATCH, SEQ, D_MODEL), f32),
        "norm_mix": 1.0 + nrm(ks[1], (L, D_MODEL), 0.02),
        "w_in": nrm(ks[2], (L, D_MODEL, IN_WIDTH), D_MODEL ** -0.5),
        "w_pool": nrm(ks[3], (L, N_POOL_GROUPS, POOL_GROUP, POOL_GROUP), POOL_GROUP ** -0.5),
        "pool_scale": 1.0 + nrm(ks[4], (L, POOL_WIDTH), 0.1),
        "lambda_q1": nrm(ks[5], (L, DIFF_HEAD_DIM), 0.1),
        "lambda_k1": nrm(ks[6], (L, DIFF_HEAD_DIM), 0.1),
        "lambda_q2": nrm(ks[7], (L, DIFF_HEAD_DIM), 0.1),
        "lambda_k2": nrm(ks[8], (L, DIFF_HEAD_DIM), 0.1),
        "subln_gain": 1.0 + nrm(ks[9], (L, 2 * DIFF_HEAD_DIM), 0.02),
        "w_out": nrm(ks[10], (L, MIX_WIDTH, D_MODEL), MIX_WIDTH ** -0.5),
        "norm_ffn": 1.0 + nrm(ks[11], (L, D_MODEL), 0.02),
        "w_gate_up": nrm(ks[12], (L, D_MODEL, 2 * FFN_HIDDEN), D_MODEL ** -0.5),
        "w_down": nrm(ks[13], (L, FFN_HIDDEN, D_MODEL), FFN_HIDDEN ** -0.5),
        "norm_final": 1.0 + nrm(ks[14], (D_MODEL,), 0.02),
    }


def reference(x, norm_mix, w_in, w_pool, pool_scale, lambda_q1, lambda_k1, lambda_q2,
              lambda_k2, subln_gain, w_out, norm_ffn, w_gate_up, w_down, norm_final):
    B, S, _ = x.shape
    cos, sin = rotary_tables(S, DIFF_HEAD_DIM)
    for l in range(DEPTH):
        h = rms_norm(x, norm_mix[l])
        proj = h @ w_in[l]
        u = proj[..., :POOL_WIDTH]
        q = proj[..., POOL_WIDTH:POOL_WIDTH + QK_WIDTH]
        k = proj[..., POOL_WIDTH + QK_WIDTH:POOL_WIDTH + 2 * QK_WIDTH]
        v = proj[..., POOL_WIDTH + 2 * QK_WIDTH:]
        q = apply_rotary(q.reshape(B, S, N_DIFF_HEADS, 2, DIFF_HEAD_DIM), cos, sin)
        k = apply_rotary(k.reshape(B, S, N_DIFF_HEADS, 2, DIFF_HEAD_DIM), cos, sin)
        v = v.reshape(B, S, N_DIFF_HEADS, 2 * DIFF_HEAD_DIM)
        lam_init = 0.8 - 0.6 * math.exp(-0.3 * l)
        lam = (jnp.exp(jnp.sum(lambda_q1[l].astype(jnp.float32) * lambda_k1[l].astype(jnp.float32)))
               - jnp.exp(jnp.sum(lambda_q2[l].astype(jnp.float32) * lambda_k2[l].astype(jnp.float32)))
               + lam_init)
        pool_out = multiscale_pool(u, w_pool[l], pool_scale[l])
        attn_out = diff_attention(q, k, v, lam, lam_init, subln_gain[l])
        mixed = jnp.concatenate([pool_out, attn_out.astype(pool_out.dtype)], axis=-1)
        x = x + mixed @ w_out[l]
        h = rms_norm(x, norm_ffn[l])
        gu = h @ w_gate_up[l]
        gate, up = gu[..., :FFN_HIDDEN], gu[..., FFN_HIDDEN:]
        x = x + (jax.nn.silu(gate) * up) @ w_down[l]
    return rms_norm(x, norm_final)
```

```cpp
#include <hip/hip_runtime.h>
#include <cstdio>
#include <cstdint>
#ifndef DEBUG_CHECK
#define DEBUG_CHECK 0
#endif
#ifndef MK_N_LAUNCHES
#define MK_N_LAUNCHES 1
#endif
constexpr int BATCH = 4, SEQ = 2048, DMODEL = 2048, MROWS = BATCH * SEQ;
constexpr int POOLW = 1024, QKW = 1024, ATTW = 1024, INW = 4096, NHEAD = 8, HDIM = 64, VDIM = 128;
constexpr int FFN = 5632, GUW = 2 * FFN;
constexpr float NORM_EPS = 1e-6f;
constexpr float QSCALE = 0.125f * 1.4426950408889634f;
namespace pg8 {
#define PG8_LAS __attribute__((address_space(3)))
typedef unsigned short bf16_t;
typedef short bf16x8 __attribute__((ext_vector_type(8)));
typedef float f32x4 __attribute__((ext_vector_type(4)));
typedef unsigned u32x4 __attribute__((ext_vector_type(4)));
constexpr int BM = 256, BK = 64, HALF = 128, HTB = HALF * BK * 2  , STAGE_BYTES = 8 * HTB, NXCD = 8, WGM = 8;

__host__ __device__ __forceinline__ int lds_byte(int r, int c) { const int st = (r >> 4) * 2 + (c >> 5), rr = r & 15, cc = c & 31, ob = rr * 64 + cc * 2; return st * 1024 + (ob ^ (((ob >> 9) & 1) << 5)); }
__host__ __device__ __forceinline__ void stage_rc(int b, int& R, int& C) { const int st = b / 1024, sb = b % 1024, swz = sb ^ (((sb >> 9) & 1) << 5); R = (st >> 1) * 16 + swz / 64; C = (st & 1) * 32 + (swz % 64) / 2; }
__host__ __device__ __forceinline__ int perm32(int rho) { const int n = rho >> 4, i = rho & 15; return 8 * (i >> 2) + 4 * n + (i & 3); }

struct Unit { int pm, pn; };
struct Gemm { const bf16_t* A; const bf16_t* Bt; int M, N, K; };

struct StaticOrder {
    int nM, nN, nwg, G, c;
    __host__ __device__ void init(int M, int N, int G_, int c_) { nM = M / BM; nN = N / BM; nwg = nM * nN; G = G_; c = c_; }
    __host__ __device__ bool next(int i, Unit& u) const {
        const long L = (long)i * G + c; if (L >= nwg) return false;
        int wgid = (int)L; { const int q = nwg / NXCD, r = nwg % NXCD, xcd = wgid % NXCD, off = wgid / NXCD; wgid = (xcd < r ? xcd * (q + 1) : r * (q + 1) + (xcd - r) * q) + off; }
        const int nig = WGM * nN, gid = wgid / nig, fm = gid * WGM, gsz = (nM - fm) < WGM ? (nM - fm) : WGM;
        u.pm = fm + ((wgid % nig) % gsz); u.pn = (wgid % nig) / gsz; return true;
    }
    __device__ __forceinline__ void a_ready(const Unit&) const {}
    __device__ __forceinline__ void done(const Unit&) const {}
};

__device__ __forceinline__ unsigned cvt_pk_bf16(float lo, float hi) { unsigned r; asm volatile("v_cvt_pk_bf16_f32 %0, %1, %2" : "=v"(r) : "v"(lo), "v"(hi)); return r; }
typedef float f32x2 __attribute__((ext_vector_type(2)));
typedef unsigned u32x2 __attribute__((ext_vector_type(2)));
struct EpiInProj {
    static constexpr bool PERM = true, AFTER_DRAIN = false;
    bf16_t *U, *Q, *Kb, *V; const float* rope;
    __device__ __forceinline__ void operator()(const f32x4 (&acc)[2][2][4][2], const Unit& u, int wr, int wc, int fr, int fq) const {
        const int row0 = u.pm * BM + wr * 64 + fr; const int pn = u.pn, colt = (pn & 3) * BM;
        if (pn < 4 || pn >= 12) {
            bf16_t* base = pn < 4 ? U : V; const int col0 = colt + wc * 32 + 8 * fq;
#pragma unroll
            for (int ai = 0; ai < 2; ++ai)
#pragma unroll
                for (int m = 0; m < 4; ++m) { bf16_t* rowp = base + (size_t)(row0 + ai * HALF + m * 16) * 1024 + col0;
#pragma unroll
                    for (int bj = 0; bj < 2; ++bj) { const f32x4 v0 = acc[ai][bj][m][0], v1 = acc[ai][bj][m][1];
                        u32x4 w; w.x = cvt_pk_bf16(v0[0], v0[1]); w.y = cvt_pk_bf16(v0[2], v0[3]); w.z = cvt_pk_bf16(v1[0], v1[1]); w.w = cvt_pk_bf16(v1[2], v1[3]);
                        *(u32x4*)(rowp + bj * HALF) = w; } }
        } else {
            bf16_t* base = pn < 8 ? Q : Kb; const float sc = pn < 8 ? QSCALE : 1.0f; const int col0 = colt + 64 * wc + 8 * fq;
#pragma unroll
            for (int ai = 0; ai < 2; ++ai)
#pragma unroll
                for (int m = 0; m < 4; ++m) { const int row = row0 + ai * HALF + m * 16; const int pos = row & 2047;
                    const f32x4* rp = (const f32x4*)(rope + (size_t)pos * 64 + 16 * fq);
                    const f32x4 t0 = rp[0], t1 = rp[1], t2 = rp[2], t3 = rp[3];
                    const float cs[8] = {t0[0], t0[2], t1[0], t1[2], t2[0], t2[2], t3[0], t3[2]}, sn[8] = {t0[1], t0[3], t1[1], t1[3], t2[1], t2[3], t3[1], t3[3]};
                    float o1[8], o2[8];
#pragma unroll
                    for (int i = 0; i < 8; ++i) { const float x1 = acc[ai][0][m][i >> 2][i & 3], x2 = acc[ai][1][m][i >> 2][i & 3];
                        o1[i] = (x1 * cs[i] - x2 * sn[i]) * sc; o2[i] = (x1 * sn[i] + x2 * cs[i]) * sc; }
                    bf16_t* rowp = base + (size_t)row * 1024 + col0;
                    u32x4 w; w.x = cvt_pk_bf16(o1[0], o1[1]); w.y = cvt_pk_bf16(o1[2], o1[3]); w.z = cvt_pk_bf16(o1[4], o1[5]); w.w = cvt_pk_bf16(o1[6], o1[7]);
                    *(u32x4*)(rowp) = w;
                    w.x = cvt_pk_bf16(o2[0], o2[1]); w.y = cvt_pk_bf16(o2[2], o2[3]); w.z = cvt_pk_bf16(o2[4], o2[5]); w.w = cvt_pk_bf16(o2[6], o2[7]);
                    *(u32x4*)(rowp + 32) = w; }
        }
    }
};
struct EpiSwiGlu {
    static constexpr bool PERM = true, AFTER_DRAIN = false;
    bf16_t* act; const float* ssq;
    __device__ __forceinline__ void operator()(const f32x4 (&acc)[2][2][4][2], const Unit& u, int wr, int wc, int fr, int fq) const {
        const int row0 = u.pm * BM + wr * 64 + fr; const int col0 = u.pn * HALF + wc * 32 + 8 * fq;
#pragma unroll
        for (int ai = 0; ai < 2; ++ai)
#pragma unroll
            for (int m = 0; m < 4; ++m) { const int row = row0 + ai * HALF + m * 16;
                const f32x4 sa = *(const f32x4*)(ssq + (size_t)row * 8), sb = *(const f32x4*)(ssq + (size_t)row * 8 + 4);
                const float tot = ((sa[0] + sa[1]) + (sa[2] + sa[3])) + ((sb[0] + sb[1]) + (sb[2] + sb[3]));
                const float r = 1.0f / sqrtf(tot * (1.0f / 2048.0f) + NORM_EPS);
                float o[8];
#pragma unroll
                for (int i = 0; i < 8; ++i) { const float g = acc[ai][0][m][i >> 2][i & 3] * r, up = acc[ai][1][m][i >> 2][i & 3] * r;
                    const float e = __builtin_amdgcn_exp2f(g * -1.4426950408889634f); o[i] = g * __builtin_amdgcn_rcpf(1.0f + e) * up; }
                u32x4 w; w.x = cvt_pk_bf16(o[0], o[1]); w.y = cvt_pk_bf16(o[2], o[3]); w.z = cvt_pk_bf16(o[4], o[5]); w.w = cvt_pk_bf16(o[6], o[7]);
                *(u32x4*)(act + (size_t)row * FFN + col0) = w; }
    }
};
struct EpiResSsq {
    static constexpr bool PERM = false, AFTER_DRAIN = true;
    const float* base; float* out; bf16_t* xb; const float* gain; float* ssq;
    __device__ __forceinline__ void fused(f32x4 (&acc)[2][2][4][2], const Unit& u, int wr, int wc, int fr, int fq, PG8_LAS unsigned char* lds, int wid, int lane) const {
        PG8_LAS float* P = (PG8_LAS float*)lds;
        const int col0 = u.pn * BM + wc * 32 + 4 * fq;
#pragma unroll
        for (int ai = 0; ai < 2; ++ai)
#pragma unroll
            for (int m = 0; m < 4; ++m) { const int r = ai * HALF + wr * 64 + m * 16 + fr; const size_t off = (size_t)(u.pm * BM + r) * DMODEL + col0; float s = 0.f;
#pragma unroll
                for (int bj = 0; bj < 2; ++bj)
#pragma unroll
                    for (int n = 0; n < 2; ++n) { const f32x4 bs = *(const f32x4*)(base + off + bj * HALF + n * 16); const f32x4 v = acc[ai][bj][m][n] + bs;
                        *(f32x4*)(out + off + bj * HALF + n * 16) = v; s += (v[0] * v[0] + v[1] * v[1]) + (v[2] * v[2] + v[3] * v[3]);
                        if (xb) { const f32x4 g = *(const f32x4*)(gain + col0 + bj * HALF + n * 16); u32x2 w; w.x = cvt_pk_bf16(v[0] * g[0], v[1] * g[1]); w.y = cvt_pk_bf16(v[2] * g[2], v[3] * g[3]);
                            *(u32x2*)(xb + off + bj * HALF + n * 16) = w; } }
                s += __shfl_xor(s, 16); s += __shfl_xor(s, 32);
                if (fq == 0) P[r * 4 + wc] = s; }
        asm volatile("s_waitcnt lgkmcnt(0)" ::: "memory"); __builtin_amdgcn_s_barrier(); asm volatile("" ::: "memory");
        const int tid = wid * 64 + lane;
        if (tid < 256) { const f32x4 p = *(const PG8_LAS f32x4*)(P + tid * 4); ssq[(size_t)(u.pm * BM + tid) * 8 + u.pn] = (p[0] + p[1]) + (p[2] + p[3]); }
    }
};

template <class Epi, class Sched, bool ALIGN_EPI = false, bool SP2 = false>
__device__ __forceinline__ void gemm_phase(PG8_LAS unsigned char* lds, const Gemm g, const Sched& S, const Epi& E) {
    const int tid = threadIdx.x, wid = __builtin_amdgcn_readfirstlane(tid >> 6), lane = tid & 63, wr = wid >> 2, wc = wid & 3, fr = lane & 15, fq = lane >> 4;
    const int K = g.K, nt = K / BK;
    unsigned voffA[2], voffB[2];
#pragma unroll
    for (int i = 0; i < 2; ++i) { int R, C; stage_rc(tid * 16 + i * 8192, R, C); const int Rb = Epi::PERM ? ((R & ~31) + perm32(R & 31)) : R;
        voffA[i] = (unsigned)(R * K + C) * 2u; voffB[i] = (unsigned)(Rb * K + C) * 2u; }
    const size_t kstep = (size_t)(BK * 2);
    const size_t hstep = (size_t)HALF * K * 2;
    const size_t tstep = 2 * hstep;
    const unsigned ldsw = (unsigned)wid * 1024u;
    const int aoff = lds_byte(wr * 64 + fr, fq * 8), boff = lds_byte(wc * 32 + fr, fq * 8);
#define PG8_SA(b, h) (((b) * 2 + (h)) * HTB)
#define PG8_SB(b, h) ((4 + (b) * 2 + (h)) * HTB)
#define PG8_STAGE(bufoff, gbase, voff) do { _Pragma("unroll") for (int _i = 0; _i < 2; ++_i) \
        __builtin_amdgcn_global_load_lds((const unsigned*)((const char*)(gbase) + (voff)[_i]), (PG8_LAS unsigned*)(lds + (bufoff) + ldsw + _i * 8192), 16, 0, 0); } while (0)
#define PG8_LDA(dst, b, h) do { _Pragma("unroll") for (int m = 0; m < 4; ++m) _Pragma("unroll") for (int k = 0; k < 2; ++k) dst[m][k] = *(const PG8_LAS bf16x8*)(lds + PG8_SA(b, h) + aoff + m * 2048 + k * 1024); } while (0)
#define PG8_LDB(dst, b, h) do { _Pragma("unroll") for (int n = 0; n < 2; ++n) _Pragma("unroll") for (int k = 0; k < 2; ++k) dst[n][k] = *(const PG8_LAS bf16x8*)(lds + PG8_SB(b, h) + boff + n * 2048 + k * 1024); } while (0)
#define PG8_MMA(ai, bj, At, Bt) do { __builtin_amdgcn_s_setprio(1); _Pragma("unroll") for (int m = 0; m < 4; ++m) _Pragma("unroll") for (int n = 0; n < 2; ++n) _Pragma("unroll") for (int k = 0; k < 2; ++k) \
        acc[ai][bj][m][n] = __builtin_amdgcn_mfma_f32_16x16x32_bf16(Bt[n][k], At[m][k], acc[ai][bj][m][n], 0, 0, 0); __builtin_amdgcn_s_setprio(0); } while (0)
#define PG8_WAIT_V(n) asm volatile("s_waitcnt vmcnt(" #n ")" ::: "memory")
#define PG8_WAIT_L(n) asm volatile("s_waitcnt lgkmcnt(" #n ")" ::: "memory")
#define PG8_BAR __builtin_amdgcn_s_barrier()
#define PG8_SCHED __builtin_amdgcn_sched_barrier(0)
    Unit cur, nxt; int ui = 0;
    if (!S.next(0, cur)) return;
    f32x4 acc[2][2][4][2];
#pragma unroll
    for (int a = 0; a < 2; ++a)
#pragma unroll
        for (int b = 0; b < 2; ++b)
#pragma unroll
            for (int m = 0; m < 4; ++m)
#pragma unroll
                for (int n = 0; n < 2; ++n) acc[a][b][m][n] = (f32x4){0.f, 0.f, 0.f, 0.f};
    bf16x8 At[4][2], B0[2][2], B1[2][2];
    const char* cA = (const char*)g.A + (size_t)cur.pm * tstep; const char* cB = (const char*)g.Bt + (size_t)cur.pn * tstep;
    S.a_ready(cur);
    if constexpr (SP2) {
        PG8_STAGE(PG8_SB(0, 0), cB, voffB); PG8_STAGE(PG8_SB(0, 1), cB + hstep, voffB); PG8_STAGE(PG8_SA(0, 0), cA, voffA); PG8_STAGE(PG8_SA(0, 1), cA + hstep, voffA);
        if (wr == 1) PG8_BAR;
        PG8_WAIT_V(2); PG8_BAR;
        PG8_STAGE(PG8_SB(1, 0), cB + kstep, voffB); PG8_STAGE(PG8_SA(1, 0), cA + kstep, voffA); PG8_STAGE(PG8_SB(1, 1), cB + hstep + kstep, voffB);
        PG8_WAIT_V(6); PG8_BAR;
    } else {
        PG8_STAGE(PG8_SB(0, 0), cB, voffB); PG8_STAGE(PG8_SA(0, 0), cA, voffA); PG8_STAGE(PG8_SB(0, 1), cB + hstep, voffB); PG8_STAGE(PG8_SA(0, 1), cA + hstep, voffA);
        if (wr == 1) PG8_BAR;
        PG8_WAIT_V(4); PG8_BAR;
        PG8_STAGE(PG8_SB(1, 0), cB + kstep, voffB); PG8_STAGE(PG8_SA(1, 0), cA + kstep, voffA); PG8_STAGE(PG8_SB(1, 1), cB + hstep + kstep, voffB);
        PG8_WAIT_V(6); PG8_BAR;
    }
    for (;;) {
        const bool has_next = S.next(ui + 1, nxt);
        const char* nA = has_next ? (const char*)g.A + (size_t)nxt.pm * tstep : cA; const char* nB = has_next ? (const char*)g.Bt + (size_t)nxt.pn * tstep : cB;
        for (int t = 0; t < nt; t += 2) {
            const bool last = (t == nt - 2);
            const char* a1 = cA + (size_t)(t + 1) * kstep;
            const char* a2 = last ? nA : cA + (size_t)(t + 2) * kstep; const char* b2 = last ? nB : cB + (size_t)(t + 2) * kstep;
            const char* a3 = a2 + kstep; const char* b3 = b2 + kstep;
            if (last && has_next) S.a_ready(nxt);
            if constexpr (SP2) {
            PG8_LDB(B0, 0, 0); PG8_LDB(B1, 0, 1); PG8_SCHED; PG8_LDA(At, 0, 0); PG8_STAGE(PG8_SA(1, 1), a1 + hstep, voffA);
            PG8_WAIT_V(8); PG8_WAIT_L(0); PG8_BAR; PG8_MMA(0, 0, At, B0); PG8_MMA(0, 1, At, B1); PG8_BAR; PG8_SCHED;
            PG8_LDA(At, 0, 1); PG8_STAGE(PG8_SB(0, 0), b2, voffB); PG8_STAGE(PG8_SB(0, 1), b2 + hstep, voffB); PG8_STAGE(PG8_SA(0, 0), a2, voffA);
            PG8_WAIT_V(8); PG8_WAIT_L(0); PG8_BAR; PG8_MMA(1, 0, At, B0); PG8_MMA(1, 1, At, B1); PG8_BAR; PG8_SCHED;
            PG8_LDB(B0, 1, 0); PG8_LDB(B1, 1, 1); PG8_SCHED; PG8_LDA(At, 1, 0); PG8_STAGE(PG8_SA(0, 1), a2 + hstep, voffA);
            PG8_WAIT_V(8); PG8_WAIT_L(0); PG8_BAR; PG8_MMA(0, 0, At, B0); PG8_MMA(0, 1, At, B1); PG8_BAR; PG8_SCHED;
            PG8_LDA(At, 1, 1); PG8_STAGE(PG8_SB(1, 0), b3, voffB); PG8_STAGE(PG8_SB(1, 1), b3 + hstep, voffB); PG8_STAGE(PG8_SA(1, 0), a3, voffA);
            PG8_WAIT_V(8); PG8_WAIT_L(0); PG8_BAR; PG8_MMA(1, 0, At, B0); PG8_MMA(1, 1, At, B1); PG8_BAR; PG8_SCHED;
            } else {
            PG8_LDB(B0, 0, 0); PG8_SCHED; PG8_LDA(At, 0, 0); PG8_STAGE(PG8_SA(1, 1), a1 + hstep, voffA);
            PG8_WAIT_L(8); PG8_BAR; PG8_WAIT_L(0); PG8_MMA(0, 0, At, B0); PG8_BAR; PG8_SCHED;
            PG8_LDB(B1, 0, 1); PG8_STAGE(PG8_SB(0, 0), b2, voffB);
            PG8_BAR; PG8_WAIT_L(0); PG8_MMA(0, 1, At, B1); PG8_BAR;
            PG8_LDA(At, 0, 1); PG8_STAGE(PG8_SA(0, 0), a2, voffA);
            PG8_BAR; PG8_WAIT_L(0); PG8_MMA(1, 0, At, B0); PG8_BAR; PG8_SCHED;
            PG8_STAGE(PG8_SB(0, 1), b2 + hstep, voffB);
            PG8_WAIT_V(6); PG8_BAR; PG8_MMA(1, 1, At, B1); PG8_BAR;
            PG8_LDB(B0, 1, 0); PG8_SCHED; PG8_LDA(At, 1, 0); PG8_STAGE(PG8_SA(0, 1), a2 + hstep, voffA);
            PG8_WAIT_L(8); PG8_BAR; PG8_WAIT_L(0); PG8_MMA(0, 0, At, B0); PG8_BAR; PG8_SCHED;
            PG8_LDB(B1, 1, 1); PG8_STAGE(PG8_SB(1, 0), b3, voffB);
            PG8_BAR; PG8_WAIT_L(0); PG8_MMA(0, 1, At, B1); PG8_BAR;
            PG8_LDA(At, 1, 1); PG8_STAGE(PG8_SA(1, 0), a3, voffA);
            PG8_BAR; PG8_WAIT_L(0); PG8_MMA(1, 0, At, B0); PG8_BAR; PG8_SCHED;
            PG8_STAGE(PG8_SB(1, 1), b3 + hstep, voffB);
            PG8_WAIT_V(6); PG8_BAR; PG8_MMA(1, 1, At, B1); PG8_BAR;
            }
        }
        if constexpr (ALIGN_EPI) { if (wr == 0) PG8_BAR; }
        if constexpr (!Epi::AFTER_DRAIN) { E(acc, cur, wr, wc, fr, fq); S.done(cur); }
        if (!has_next) break;
#pragma unroll
        for (int a = 0; a < 2; ++a)
#pragma unroll
            for (int b = 0; b < 2; ++b)
#pragma unroll
                for (int m = 0; m < 4; ++m)
#pragma unroll
                    for (int n = 0; n < 2; ++n) acc[a][b][m][n] = (f32x4){0.f, 0.f, 0.f, 0.f};
        cur = nxt; cA = nA; cB = nB; ++ui;
        if constexpr (ALIGN_EPI) { if (wr == 1) PG8_BAR; }
    }
    PG8_WAIT_V(0);
    if constexpr (!ALIGN_EPI) { if (wr == 0) PG8_BAR; }
    PG8_BAR;
    if constexpr (Epi::AFTER_DRAIN) { E.fused(acc, cur, wr, wc, fr, fq, lds, wid, lane); S.done(cur); }
#undef PG8_SA
#undef PG8_SB
#undef PG8_STAGE
#undef PG8_LDA
#undef PG8_LDB
#undef PG8_MMA
#undef PG8_WAIT_V
#undef PG8_WAIT_L
#undef PG8_BAR
#undef PG8_SCHED
}
}
#define GAS __attribute__((address_space(1)))
#define LAS __attribute__((address_space(3)))
typedef unsigned short bf16;
typedef unsigned v4u __attribute__((ext_vector_type(4)));
typedef float f32x4 __attribute__((ext_vector_type(4)));
typedef short bf16x8 __attribute__((ext_vector_type(8)));
typedef GAS unsigned gu32;
typedef GAS unsigned long long gu64;
#define RLX_AGENT __ATOMIC_RELAXED, __HIP_MEMORY_SCOPE_AGENT
#define LDS_WAIT() asm volatile("s_waitcnt lgkmcnt(0)" ::: "memory")
#define VM_WAIT() asm volatile("s_waitcnt vmcnt(0)" ::: "memory")
__device__ __forceinline__ unsigned long long rt() { return __builtin_amdgcn_s_memrealtime(); }
__device__ __forceinline__ unsigned f2bf(float f) { unsigned u = __builtin_bit_cast(unsigned, f); return (u + 0x7fffu + ((u >> 16) & 1u)) >> 16; }
__device__ __forceinline__ unsigned pk2(float lo, float hi) { return f2bf(lo) | (f2bf(hi) << 16); }

#define XB_TMO      128
#define XB_XCNT(j)  (256  + 64 * (j))
#define XB_XSUB(j)  (1280 + 64 * (j))
#define XB_XGEN(j)  (2304 + 64 * (j))
#define XB_TOP      3328
#define XB_TOPGEN   3392
#define XCD_BAR_WORDS 3456
#define XB_SPIN_CAP (1u << 18)

__device__ __forceinline__ unsigned xb_ld(unsigned* p)              { return __hip_atomic_load(p, __ATOMIC_RELAXED, __HIP_MEMORY_SCOPE_AGENT); }
__device__ __forceinline__ unsigned xb_add(unsigned* p, unsigned v) { return __hip_atomic_fetch_add(p, v, __ATOMIC_RELAXED, __HIP_MEMORY_SCOPE_AGENT); }
__device__ __forceinline__ unsigned xb_xcc_id() { return (unsigned)__builtin_amdgcn_s_getreg((3 << 11) | 20) & 0xFu; }
#define XB_SPIN(cond, bar) do { unsigned _sp = 0; while (cond) { __builtin_amdgcn_s_sleep(1); \
    if ((++_sp & 255u) == 0u) { if (xb_ld(&(bar)[XB_TMO])) break; if (_sp > XB_SPIN_CAP) { atomicAdd(&(bar)[XB_TMO], 1u); break; } } } } while (0)

struct XcdBarrier {
    unsigned* bar; unsigned x;
    volatile LAS unsigned* st;
};

__device__ __forceinline__ XcdBarrier xcd_barrier_post(unsigned* bar, volatile LAS unsigned* st) {
    XcdBarrier b; b.bar = bar; b.x = xb_xcc_id(); b.st = st;
    if (threadIdx.x == 0) (void)xb_add(&bar[XB_XCNT(b.x)], 1u);
    return b;
}
__device__ __forceinline__ void xcd_barrier_complete(unsigned* bar, unsigned x, unsigned& nloc, unsigned& nx) {
    const unsigned G = gridDim.x * gridDim.y * gridDim.z;
    unsigned sum, cnt, mine, sp = 0u;
    for (;;) {
        sum = 0u; cnt = 0u; mine = 0u;
#pragma unroll
        for (unsigned j = 0; j < 16; ++j) { const unsigned c = xb_ld(&bar[XB_XCNT(j)]); sum += c; cnt += (c > 0u) ? 1u : 0u; mine = (j == x) ? c : mine; }
        if (sum == G) break;
        __builtin_amdgcn_s_sleep(1);
        if ((++sp & 255u) == 0u) { if (xb_ld(&bar[XB_TMO])) break; if (sp > XB_SPIN_CAP) { atomicAdd(&bar[XB_TMO], 1u); break; } }
    }
    nloc = mine > 0u ? mine : 1u; nx = cnt > 0u ? cnt : 1u;
}

__device__ __forceinline__ void xcd_barrier(const XcdBarrier& b) {
    asm volatile("s_waitcnt vmcnt(0)" ::: "memory");
    __syncthreads();
    if (threadIdx.x == 0) {
        unsigned* bar = b.bar;
        __builtin_amdgcn_s_waitcnt(0);
        unsigned nloc = b.st[0], nx = b.st[1];
        if (nloc == 0u) { xcd_barrier_complete(bar, b.x, nloc, nx); b.st[0] = nloc; b.st[1] = nx; }
        const unsigned old = xb_add(&bar[XB_XSUB(b.x)], 1u);
        const unsigned gen = old / nloc;
        if (old + 1u == (gen + 1u) * nloc) {
            __builtin_amdgcn_fence(__ATOMIC_RELEASE, "agent");
            asm volatile("s_waitcnt vmcnt(0)" ::: "memory");
            const unsigned og = xb_add(&bar[XB_TOP], 1u);
            const unsigned tg = og / nx;
            if (og + 1u == (tg + 1u) * nx) xb_add(&bar[XB_TOPGEN], 1u);
            else XB_SPIN(xb_ld(&bar[XB_TOPGEN]) == tg, bar);
            __builtin_amdgcn_fence(__ATOMIC_ACQUIRE, "agent");
            xb_add(&bar[XB_XGEN(b.x)], 1u);
            asm volatile("s_waitcnt vmcnt(0)" ::: "memory");
        } else {
            XB_SPIN(xb_ld(&bar[XB_XGEN(b.x)]) == gen, bar);
            __builtin_amdgcn_fence(__ATOMIC_ACQUIRE, "agent");
            asm volatile("s_waitcnt vmcnt(0)" ::: "memory");
        }
    }
    __syncthreads();
}
namespace mix {
typedef short bf16x8 __attribute__((ext_vector_type(8)));
typedef short s16x4 __attribute__((ext_vector_type(4)));
typedef short v4i16_t __attribute__((ext_vector_type(4)));
typedef float f32x16 __attribute__((ext_vector_type(16)));
typedef float f32x4 __attribute__((ext_vector_type(4)));
typedef unsigned u32x4 __attribute__((ext_vector_type(4)));
typedef unsigned u32x2 __attribute__((ext_vector_type(2)));
typedef unsigned short bf16;
typedef __attribute__((address_space(3))) const char* lds_cptr;
typedef __attribute__((address_space(3))) char* lds_ptr;
constexpr int PITCH = 1024;
constexpr int SLOT = 32768, NSLOT = 2, LDS_WS = NSLOT * SLOT, ATTN_LDS_BYTES = LDS_WS + 8 * 256;
constexpr int POOL_ROW_B = 528, POOL_LDS_BYTES = 128 * POOL_ROW_B;
constexpr float THR = 8.0f;
__device__ __forceinline__ int crow(int r, int hi) { return (r & 3) + 8 * (r >> 2) + 4 * hi; }
__device__ __forceinline__ unsigned cvtpk(float lo, float hi) { unsigned r; asm volatile("v_cvt_pk_bf16_f32 %0, %1, %2" : "=v"(r) : "v"(lo), "v"(hi)); return r; }
__device__ __forceinline__ float bf2f(unsigned short v) { return __uint_as_float((unsigned)v << 16); }
__device__ __forceinline__ void glds16(const void* gsrc, unsigned lds_dst) { unsigned keep;
    asm volatile("s_mov_b32 %0, m0\n\ts_mov_b32 m0, %2\n\ts_nop 0\n\tglobal_load_lds_dwordx4 %1, off\n\ts_mov_b32 m0, %0" : "=&s"(keep) : "v"(gsrc), "s"(lds_dst) : "memory"); }
__device__ __forceinline__ s16x4 vtr(lds_cptr p) { return __builtin_bit_cast(s16x4, __builtin_amdgcn_ds_read_tr16_b64_v4i16((__attribute__((address_space(3))) v4i16_t*)p)); }
#define MIX_MFMA32(a, b, c) __builtin_amdgcn_mfma_f32_32x32x16_bf16(a, b, c, 0, 0, 0)
#define MIX_MFMA16(a, b, c) __builtin_amdgcn_mfma_f32_16x16x32_bf16(a, b, c, 0, 0, 0)

__device__ __forceinline__ void pool_unit(int rb, int g, const bf16* __restrict__ U, const bf16* __restrict__ Wt, const float* __restrict__ pscale, bf16* MIX, lds_ptr shm) {
    const int tid = threadIdx.x, lane = tid & 63, wid = __builtin_amdgcn_readfirstlane(tid >> 6);
    const int w = 2 << g;
    {
        const int ch8 = tid & 31, slab = tid >> 5; const int r0 = rb * 128 + slab * 8; const int pos0 = r0 & (SEQ - 1);
        const bf16* up = U + (size_t)r0 * PITCH + g * 256 + ch8 * 8;
        float s[8];
#pragma unroll
        for (int i = 0; i < 8; ++i) s[i] = 0.f;
        for (int j = 1; j < w; ++j) if (pos0 - j >= 0) { const u32x4 v = *(const u32x4*)(up - (long)j * PITCH);
#pragma unroll
            for (int i = 0; i < 4; ++i) { s[2 * i] += __uint_as_float(v[i] << 16); s[2 * i + 1] += __uint_as_float(v[i] & 0xffff0000u); } }
#pragma unroll
        for (int rr = 0; rr < 8; ++rr) { const int pos = pos0 + rr; const u32x4 v = *(const u32x4*)(up + (size_t)rr * PITCH);
            float cur[8];
#pragma unroll
            for (int i = 0; i < 4; ++i) { cur[2 * i] = __uint_as_float(v[i] << 16); cur[2 * i + 1] = __uint_as_float(v[i] & 0xffff0000u); }
#pragma unroll
            for (int i = 0; i < 8; ++i) s[i] += cur[i];
            const float inv = 1.0f / (float)(pos + 1 < w ? pos + 1 : w);
            u32x4 pk;
#pragma unroll
            for (int i = 0; i < 4; ++i) pk[i] = cvtpk(s[2 * i] * inv - cur[2 * i], s[2 * i + 1] * inv - cur[2 * i + 1]);
            *(__attribute__((address_space(3))) u32x4*)(shm + (slab * 8 + rr) * POOL_ROW_B + ch8 * 16) = pk;
            if (rr < 7 && pos - w + 1 >= 0) { const u32x4 o = *(const u32x4*)(up + (long)(rr - w + 1) * PITCH);
#pragma unroll
                for (int i = 0; i < 4; ++i) { s[2 * i] -= __uint_as_float(o[i] << 16); s[2 * i + 1] -= __uint_as_float(o[i] & 0xffff0000u); } } }
    }
    asm volatile("s_waitcnt lgkmcnt(0)\n\ts_barrier" ::: "memory");
    {
        const int wr = wid >> 2, wc = wid & 3, fr = lane & 15, fq = lane >> 4;
        f32x4 acc[4][4];
#pragma unroll
        for (int a = 0; a < 4; ++a)
#pragma unroll
            for (int b = 0; b < 4; ++b) acc[a][b] = (f32x4){0.f, 0.f, 0.f, 0.f};
        const bf16* wp = Wt + (size_t)g * 65536 + (size_t)(wc * 64 + fr) * 256 + fq * 8;
        const lds_cptr ap = (lds_cptr)shm + (wr * 64 + fr) * POOL_ROW_B + fq * 16;
#pragma unroll 2
        for (int kk = 0; kk < 8; ++kk) {
            bf16x8 wf[4], pf[4];
#pragma unroll
            for (int nt = 0; nt < 4; ++nt) wf[nt] = *(const bf16x8*)(wp + nt * 16 * 256 + kk * 32);
#pragma unroll
            for (int mt = 0; mt < 4; ++mt) pf[mt] = *(const __attribute__((address_space(3))) bf16x8*)(ap + mt * 16 * POOL_ROW_B + kk * 64);
#pragma unroll
            for (int nt = 0; nt < 4; ++nt)
#pragma unroll
                for (int mt = 0; mt < 4; ++mt) acc[nt][mt] = MIX_MFMA16(wf[nt], pf[mt], acc[nt][mt]);
        }
#pragma unroll
        for (int nt = 0; nt < 4; ++nt) { const int n0 = g * 256 + wc * 64 + nt * 16 + fq * 4; const f32x4 sc = *(const f32x4*)(pscale + n0);
#pragma unroll
            for (int mt = 0; mt < 4; ++mt) { const int row = rb * 128 + wr * 64 + mt * 16 + fr; const f32x4 v = acc[nt][mt] * sc;
                u32x2 o; o.x = cvtpk(v[0], v[1]); o.y = cvtpk(v[2], v[3]); *(u32x2*)(MIX + (size_t)row * DMODEL + n0) = o; } }
    }
    asm volatile("s_waitcnt lgkmcnt(0)\n\ts_barrier" ::: "memory");
}

__device__ __forceinline__ void attn_unit(int b, int h, int qi, const bf16* Q, const bf16* __restrict__ K, const bf16* __restrict__ V, bf16* MIX, const float* __restrict__ gain, float lam, lds_ptr shm) {
    const int tid = threadIdx.x, lane = tid & 63, r32 = lane & 31, hi = lane >> 5; const int wid = __builtin_amdgcn_readfirstlane(tid >> 6);
    const int comp = wid >> 2, rg = wid & 3;
    const long rowbase = (long)b * SEQ; const int q0 = qi * 128;
    const int NT = 2 * qi + 2, cw = 2 * qi + (rg >> 1);
    const bf16* Qw = Q + (rowbase + q0 + rg * 32) * PITCH + h * 128 + comp * 64;
    const bf16* Kh = K + rowbase * PITCH + h * 128; const bf16* Vh = V + rowbase * PITCH + h * 128;
    const unsigned lds0 = (unsigned)(uintptr_t)shm;
    __attribute__((address_space(3))) float* wsf = (__attribute__((address_space(3))) float*)(shm + LDS_WS) + wid * 64;
    const bf16* ksrc1 = Kh + (long)lane * PITCH + wid * 8; const bf16* ksrc2 = ksrc1 + 64;
    const bf16* vsrcA = Vh + (long)(16 * (wid & 3) + (lane >> 2)) * PITCH + (wid >> 2) * 32 + (lane & 3) * 8; const bf16* vsrcB = vsrcA + 64;
    const unsigned kdst1 = lds0 + wid * 1024, kdst2 = kdst1 + 8192, vdstA = lds0 + 16384 + wid * 1024, vdstB = vdstA + 8192;
#define MIX_DMA(t, slot) do { const long o_ = (long)(t) * 64 * PITCH; glds16(ksrc1 + o_, (unsigned)__builtin_amdgcn_readfirstlane(kdst1 + (slot))); glds16(ksrc2 + o_, (unsigned)__builtin_amdgcn_readfirstlane(kdst2 + (slot))); \
        glds16(vsrcA + o_, (unsigned)__builtin_amdgcn_readfirstlane(vdstA + (slot))); glds16(vsrcB + o_, (unsigned)__builtin_amdgcn_readfirstlane(vdstB + (slot))); } while (0)
    bf16x8 qr[4];
#pragma unroll
    for (int d0 = 0; d0 < 4; ++d0) qr[d0] = *(const bf16x8*)(Qw + (long)r32 * PITCH + d0 * 16 + hi * 8);
    asm volatile("s_waitcnt vmcnt(0)" ::: "memory");
    MIX_DMA(0, 0);
    float mhat = -1.0e30f, l = 0.f; f32x16 o[4];
#pragma unroll
    for (int d0 = 0; d0 < 4; ++d0)
#pragma unroll
        for (int r = 0; r < 16; ++r) o[d0][r] = 0.f;
    const lds_cptr kb0 = (lds_cptr)shm + comp * 8192 + hi * 1024 + r32 * 16;
    const lds_cptr vb0 = (lds_cptr)shm + 16384 + ((lane >> 4) & 1) * 32 + (lane & 3) * 8 + (4 * hi + ((lane & 15) >> 2)) * 64;
    for (int t = 0; t < NT; ++t) {
        const int cur = (t & 1) * SLOT;
        if (t + 1 < NT) { MIX_DMA(t + 1, ((t + 1) & 1) * SLOT); asm volatile("s_waitcnt vmcnt(4) lgkmcnt(0)\n\ts_barrier" ::: "memory"); }
        else { asm volatile("s_waitcnt vmcnt(0) lgkmcnt(0)\n\ts_barrier" ::: "memory"); }
        if (t <= cw) {
            f32x16 p0, p1;
#pragma unroll
            for (int r = 0; r < 16; ++r) { p0[r] = 0.f; p1[r] = 0.f; }
            const lds_cptr kb = kb0 + cur;
#pragma unroll
            for (int d0 = 0; d0 < 4; ++d0) { const bf16x8 b0 = *(const __attribute__((address_space(3))) bf16x8*)(kb + d0 * 2048), b1 = *(const __attribute__((address_space(3))) bf16x8*)(kb + d0 * 2048 + 512);
                p0 = MIX_MFMA32(b0, qr[d0], p0); p1 = MIX_MFMA32(b1, qr[d0], p1); }
            float rm = fmaxf(p0[0], p1[0]);
#pragma unroll
            for (int r = 1; r < 16; ++r) rm = fmaxf(rm, fmaxf(p0[r], p1[r]));
            rm = fmaxf(rm, __shfl_xor(rm, 32));
            if (__any(rm > mhat + THR)) {
                const float mnew = fmaxf(mhat, rm), f = __builtin_amdgcn_exp2f(mhat - mnew); l *= f; mhat = mnew;
                if (hi == 0) wsf[r32] = f;
                asm volatile("s_waitcnt lgkmcnt(0)" ::: "memory");
#pragma unroll
                for (int r = 0; r < 16; ++r) { const float fr_ = wsf[crow(r, hi)];
#pragma unroll
                    for (int d0 = 0; d0 < 4; ++d0) o[d0][r] *= fr_; }
            }
            float sacc = 0.f;
#pragma unroll
            for (int r = 0; r < 16; ++r) { p0[r] = __builtin_amdgcn_exp2f(p0[r] - mhat); p1[r] = __builtin_amdgcn_exp2f(p1[r] - mhat); sacc += p0[r] + p1[r]; }
            l += sacc;
            bf16x8 pw[4];
            { u32x4 w0 = {cvtpk(p0[0], p0[1]), cvtpk(p0[2], p0[3]), cvtpk(p0[4], p0[5]), cvtpk(p0[6], p0[7])}, w1 = {cvtpk(p0[8], p0[9]), cvtpk(p0[10], p0[11]), cvtpk(p0[12], p0[13]), cvtpk(p0[14], p0[15])};
              u32x4 w2 = {cvtpk(p1[0], p1[1]), cvtpk(p1[2], p1[3]), cvtpk(p1[4], p1[5]), cvtpk(p1[6], p1[7])}, w3 = {cvtpk(p1[8], p1[9]), cvtpk(p1[10], p1[11]), cvtpk(p1[12], p1[13]), cvtpk(p1[14], p1[15])};
              pw[0] = __builtin_bit_cast(bf16x8, w0); pw[1] = __builtin_bit_cast(bf16x8, w1); pw[2] = __builtin_bit_cast(bf16x8, w2); pw[3] = __builtin_bit_cast(bf16x8, w3); }
            const lds_cptr vb = vb0 + cur;
#pragma unroll
            for (int d0 = 0; d0 < 4; ++d0)
#pragma unroll
                for (int ks = 0; ks < 4; ++ks) { const s16x4 lo = vtr(vb + d0 * 4096 + ks * 1024), hh = vtr(vb + d0 * 4096 + ks * 1024 + 512);
                    const bf16x8 vf = (bf16x8){lo[0], lo[1], lo[2], lo[3], hh[0], hh[1], hh[2], hh[3]};
                    o[d0] = MIX_MFMA32(pw[ks], vf, o[d0]); }
        }
        asm volatile("s_waitcnt lgkmcnt(0)\n\ts_barrier" ::: "memory");
    }
#undef MIX_DMA
    l += __shfl_xor(l, 32);
    if (hi == 0) wsf[32 + r32] = 1.0f / l;
    asm volatile("s_waitcnt lgkmcnt(0)" ::: "memory");
    float rli[16];
#pragma unroll
    for (int r = 0; r < 16; ++r) rli[r] = wsf[32 + crow(r, hi)];
    __attribute__((address_space(3))) float* X = (__attribute__((address_space(3))) float*)shm + rg * 4096;
    if (comp == 1) {
#pragma unroll
        for (int d0 = 0; d0 < 4; ++d0)
#pragma unroll
            for (int r = 0; r < 16; ++r) X[crow(r, hi) * 128 + d0 * 32 + r32] = o[d0][r] * rli[r] * lam;
    }
    asm volatile("s_waitcnt lgkmcnt(0)\n\ts_barrier" ::: "memory");
    if (comp == 0) {
#pragma unroll
        for (int d0 = 0; d0 < 4; ++d0)
#pragma unroll
            for (int r = 0; r < 16; ++r) { const int idx = crow(r, hi) * 128 + d0 * 32 + r32; X[idx] = o[d0][r] * rli[r] - X[idx]; }
        asm volatile("s_waitcnt lgkmcnt(0)" ::: "memory");
        const int row = lane >> 1, half = lane & 1;
        const __attribute__((address_space(3))) f32x4* xr = (const __attribute__((address_space(3))) f32x4*)(X + row * 128 + half * 64);
        f32x4 v[16]; float ss = 0.f;
#pragma unroll
        for (int j = 0; j < 16; ++j) { v[j] = xr[j]; ss += (v[j][0] * v[j][0] + v[j][1] * v[j][1]) + (v[j][2] * v[j][2] + v[j][3] * v[j][3]); }
        ss += __shfl_xor(ss, 1);
        const float rn = 0.8f / sqrtf(ss * (1.0f / 128.0f) + NORM_EPS);
        bf16* op = MIX + (size_t)(rowbase + q0 + rg * 32 + row) * DMODEL + 1024 + h * 128 + half * 64;
        const f32x4* gp = (const f32x4*)(gain + half * 64);
#pragma unroll
        for (int j = 0; j < 8; ++j) { const f32x4 g0 = gp[2 * j], g1 = gp[2 * j + 1]; const f32x4 a = v[2 * j] * g0 * rn, c = v[2 * j + 1] * g1 * rn;
            u32x4 w; w.x = cvtpk(a[0], a[1]); w.y = cvtpk(a[2], a[3]); w.z = cvtpk(c[0], c[1]); w.w = cvtpk(c[2], c[3]); *(u32x4*)(op + 8 * j) = w; }
    }
    asm volatile("s_waitcnt lgkmcnt(0)\n\ts_barrier" ::: "memory");
}
}

constexpr size_t MiB = 1u << 20;
constexpr size_t WS_CTL = 0, CTL_ZERO_BYTES = 1 * MiB;
constexpr size_t WS_ROPE = 1 * MiB;
constexpr size_t WS_SSQ1 = 1 * MiB + 512 * 1024, WS_SSQ2 = WS_SSQ1 + 256 * 1024;
constexpr size_t WS_WPOOL = 2 * MiB;
constexpr size_t WS_WIN = 3 * MiB, WS_WOUT = 19 * MiB, WS_WGU = 27 * MiB, WS_WD = 71 * MiB;
constexpr size_t WS_XN = 93 * MiB;
constexpr size_t WS_U = 125 * MiB, WS_Q = 141 * MiB, WS_K = 157 * MiB, WS_V = 173 * MiB;
constexpr size_t WS_MIX = 189 * MiB;
constexpr size_t WS_ACT = 221 * MiB;
constexpr size_t WS_END = 309 * MiB;
static_assert(WS_ACT + (size_t)MROWS * FFN * 2 == WS_END && WS_WD + (size_t)DMODEL * FFN * 2 == WS_XN && WS_WGU + (size_t)GUW * DMODEL * 2 == WS_WD, "d_ws map");
constexpr int CW_TMO = 0, CW_CODE = 1, CW_ERR = 64, CW_BAR = 4096;
constexpr int RING_OFF = 0, RING_BYTES = 131072;
constexpr int LDSCTL_OFF = RING_BYTES, MISC_OFF = LDSCTL_OFF + 320;
constexpr int LDS_BYTES = 147456;
static_assert(mix::ATTN_LDS_BYTES <= RING_BYTES && mix::POOL_LDS_BYTES <= RING_BYTES, "P2 bodies fit the ring region");
constexpr int NWAVES = 8, N_PHASES = 7;

struct Frame {
    LAS unsigned char* lds; volatile LAS unsigned* MISC; gu32* ctl;
    int tid, lane, wave, vcu, G;
};
__device__ __forceinline__ float wave_sum(float v) {
#pragma unroll
    for (int o = 1; o < 64; o <<= 1) v += __shfl_xor(v, o);
    return v;
}
__device__ __forceinline__ unsigned pk_rne(float lo, float hi) { unsigned r; asm volatile("v_cvt_pk_bf16_f32 %0, %1, %2" : "=v"(r) : "v"(lo), "v"(hi)); return r; }
__device__ __forceinline__ void p0_transpose_item(const float* __restrict__ W, int K, int N, bf16* WT, int k0, int n0, int drow0, LAS float* scr, int lane) {
#pragma unroll 8
    for (int i = 0; i < 32; ++i) { const int kk = 2 * i + (lane >> 5); scr[kk * 33 + (lane & 31)] = W[(size_t)(k0 + kk) * N + n0 + (lane & 31)]; }
    LDS_WAIT(); asm volatile("" ::: "memory");
    const int c = lane & 7;
#pragma unroll
    for (int j = 0; j < 4; ++j) { const int n = (lane >> 3) + 8 * j; const LAS float* s = scr + (8 * c) * 33 + n;
        v4u o; o.x = pk_rne(s[0 * 33], s[1 * 33]); o.y = pk_rne(s[2 * 33], s[3 * 33]); o.z = pk_rne(s[4 * 33], s[5 * 33]); o.w = pk_rne(s[6 * 33], s[7 * 33]);
        *(GAS v4u*)(WT + (size_t)(drow0 + n) * K + k0 + 8 * c) = o; }
    LDS_WAIT(); asm volatile("" ::: "memory");
}
__device__ __forceinline__ void rms_row_to_bf16(const float* xrow, const float* gain, bf16* orow, int lane) {
    const GAS f32x4* xr = (const GAS f32x4*)xrow + lane; const GAS f32x4* gr = (const GAS f32x4*)gain + lane;
    f32x4 v[8]; float s = 0.f;
#pragma unroll
    for (int j = 0; j < 8; ++j) { v[j] = xr[64 * j]; s += (v[j].x * v[j].x + v[j].y * v[j].y) + (v[j].z * v[j].z + v[j].w * v[j].w); }
    const float r = 1.0f / sqrtf(wave_sum(s) * (1.0f / DMODEL) + NORM_EPS);
    GAS unsigned long long* o8 = (GAS unsigned long long*)orow + lane;
#pragma unroll
    for (int j = 0; j < 8; ++j) { const f32x4 g = gr[64 * j]; o8[64 * j] = (unsigned long long)pk_rne(v[j].x * r * g.x, v[j].y * r * g.y) | ((unsigned long long)pk_rne(v[j].z * r * g.z, v[j].w * r * g.w) << 32); }
}
__device__ __forceinline__ void final_norm_row(float* row, const float* ssq8, const float* gain, int lane) {
    const f32x4 sa = *(const GAS f32x4*)ssq8, sb = *((const GAS f32x4*)ssq8 + 1);
    const float tot = ((sa.x + sa.y) + (sa.z + sa.w)) + ((sb.x + sb.y) + (sb.z + sb.w));
    const float r = 1.0f / sqrtf(tot * (1.0f / DMODEL) + NORM_EPS);
    GAS f32x4* xr = (GAS f32x4*)row + lane; const GAS f32x4* gr = (const GAS f32x4*)gain + lane;
#pragma unroll
    for (int j = 0; j < 8; ++j) { const f32x4 v = xr[64 * j], g = gr[64 * j]; xr[64 * j] = v * g * r; }
}
struct Args { const float* in[15]; float* out; unsigned char* ws; float inv_freq[32]; int ph_lo, ph_hi; };

__device__ __forceinline__ void p0_prologue(Frame& F, const Args& a) {
    LAS float* scr = (LAS float*)(F.lds + RING_OFF + F.wave * 16384);
    const int gw = F.vcu * NWAVES + F.wave, NGW = F.G * NWAVES;
    unsigned char* ws = a.ws;
    const float *w_in = a.in[2], *w_pool = a.in[3], *w_out = a.in[10], *w_gu = a.in[12], *w_d = a.in[13];
    bf16 *Win = (bf16*)(ws + WS_WIN), *Wout = (bf16*)(ws + WS_WOUT), *Wgu = (bf16*)(ws + WS_WGU), *Wd = (bf16*)(ws + WS_WD), *Wp = (bf16*)(ws + WS_WPOOL);
    constexpr int I_IN = (DMODEL / 64) * (INW / 32), I_OUT = (DMODEL / 64) * (DMODEL / 32), I_GU = (DMODEL / 64) * (GUW / 32), I_D = (FFN / 64) * (DMODEL / 32), I_P = 4 * (256 / 64) * (256 / 32);
    constexpr int NITEMS = I_IN + I_OUT + I_GU + I_D + I_P;
    for (int it = gw; it < NITEMS; it += NGW) {
        int r = it;
        if (r < I_GU) { const int nblk = GUW / 32, kb = r / nblk, nb = r % nblk, n0 = 32 * nb; const int bj = n0 >= FFN ? 1 : 0, j0 = n0 - bj * FFN;
            p0_transpose_item(w_gu, DMODEL, GUW, Wgu, 64 * kb, n0, 256 * (j0 >> 7) + 128 * bj + (j0 & 127), scr, F.lane); continue; } r -= I_GU;
        if (r < I_D) { const int nblk = DMODEL / 32, kb = r / nblk, nb = r % nblk; p0_transpose_item(w_d, FFN, DMODEL, Wd, 64 * kb, 32 * nb, 32 * nb, scr, F.lane); continue; } r -= I_D;
        if (r < I_IN) { const int nblk = INW / 32, kb = r / nblk, nb = r % nblk, n0 = 32 * nb; int dr = n0;
            if (n0 >= 1024 && n0 < 3072) dr = (n0 & ~255) + 128 * ((n0 >> 5) & 1) + 32 * ((n0 >> 6) & 3);
            p0_transpose_item(w_in, DMODEL, INW, Win, 64 * kb, n0, dr, scr, F.lane); continue; } r -= I_IN;
        if (r < I_OUT) { const int nblk = DMODEL / 32, kb = r / nblk, nb = r % nblk; p0_transpose_item(w_out, DMODEL, DMODEL, Wout, 64 * kb, 32 * nb, 32 * nb, scr, F.lane); continue; } r -= I_OUT;
        { const int g = r >> 5, q = r & 31, kb = q >> 3, nb = q & 7; p0_transpose_item(w_pool + (size_t)g * 65536, 256, 256, Wp + (size_t)g * 65536, 64 * kb, 32 * nb, 32 * nb, scr, F.lane); }
    }
    const float* x = a.in[0]; bf16* XN = (bf16*)(ws + WS_XN);
    for (int m = gw; m < MROWS; m += NGW) rms_row_to_bf16(x + (size_t)m * DMODEL, a.in[1], XN + (size_t)m * DMODEL, F.lane);
    float* rope = (float*)(ws + WS_ROPE);
    for (int e = (F.vcu * NWAVES * 64 + F.tid); e < SEQ * 32; e += F.G * NWAVES * 64) { const int pos = e >> 5, j = e & 31;
        const float angf = (float)pos * a.inv_freq[j]; const double ang = (double)angf;
        const double k = __builtin_rint(ang * 0.15915494309189535); const double r = (ang - k * 6.283185307179586) - k * 2.4492935982947064e-16; const double r2 = r * r;
        double ts = r, ss = r, tc = 1.0, cc = 1.0;
#pragma unroll
        for (int i = 1; i <= 13; ++i) { ts *= -r2 / (double)((2 * i) * (2 * i + 1)); ss += ts; tc *= -r2 / (double)((2 * i - 1) * (2 * i)); cc += tc; }
        rope[2 * e] = (float)cc; rope[2 * e + 1] = (float)ss; }
}
__global__ void __launch_bounds__(NWAVES * 64, 2) fwd_kernel(Args args) {
    extern __shared__ __attribute__((aligned(16))) unsigned char lds[];
    Frame F;
    F.lds = (LAS unsigned char*)lds; F.MISC = (volatile LAS unsigned*)(F.lds + MISC_OFF);
    F.tid = threadIdx.x; F.lane = F.tid & 63; F.wave = __builtin_amdgcn_readfirstlane(F.tid >> 6);
    F.G = gridDim.x; { const int bx = blockIdx.x; F.vcu = (F.G % 8 == 0) ? (bx % 8) * (F.G / 8) + bx / 8 : bx; }
    unsigned char* ws = args.ws; F.ctl = (gu32*)(ws + WS_CTL);
    for (int u = F.tid; u < (LDS_BYTES - LDSCTL_OFF) / 4; u += NWAVES * 64) ((LAS unsigned*)(F.lds + LDSCTL_OFF))[u] = 0u;
    __syncthreads();
    const int lo = args.ph_lo, hi = args.ph_hi; const bool use_bar = (hi - lo) > 1;
    XcdBarrier bar; bar.bar = (unsigned*)(F.ctl + CW_BAR); bar.x = 0; bar.st = nullptr;
    if (use_bar) bar = xcd_barrier_post((unsigned*)(F.ctl + CW_BAR), F.MISC + 8);
#define IN(k) (lo <= (k) && (k) < hi)
#define SEAM(k) do { if (IN(k) && IN((k) + 1)) xcd_barrier(bar); } while (0)
    bf16 *XN = (bf16*)(ws + WS_XN), *Ub = (bf16*)(ws + WS_U), *Qb = (bf16*)(ws + WS_Q), *Kb = (bf16*)(ws + WS_K), *Vb = (bf16*)(ws + WS_V), *MIX = (bf16*)(ws + WS_MIX), *ACT = (bf16*)(ws + WS_ACT);
    float *ssq1 = (float*)(ws + WS_SSQ1), *ssq2 = (float*)(ws + WS_SSQ2);

    if (IN(0)) { p0_prologue(F, args); SEAM(0); }

    if (IN(1)) {
        pg8::Gemm g{XN, (const bf16*)(ws + WS_WIN), MROWS, INW, DMODEL}; pg8::StaticOrder S; S.init(MROWS, INW, F.G, (int)blockIdx.x);
        pg8::EpiInProj E{Ub, Qb, Kb, Vb, (const float*)(ws + WS_ROPE)};
        pg8::gemm_phase<pg8::EpiInProj, pg8::StaticOrder, true, true>(F.lds + RING_OFF, g, S, E);
        SEAM(1);
    }

    if (IN(2)) {
        mix::lds_ptr shm = (mix::lds_ptr)(F.lds + RING_OFF);
        for (int u = F.vcu; u < 256; u += F.G) mix::pool_unit(u >> 2, u & 3, Ub, (const bf16*)(ws + WS_WPOOL), args.in[4], MIX, shm);
        const float d1 = wave_sum(args.in[5][F.lane] * args.in[6][F.lane]), d2 = wave_sum(args.in[7][F.lane] * args.in[8][F.lane]);
        const float lam = expf(d1) - expf(d2) + 0.2f;
        for (int p = F.vcu; p < 256; p += F.G) { const int bh = p >> 3, s = p & 7;
            mix::attn_unit(bh >> 3, bh & 7, s, Qb, Kb, Vb, MIX, args.in[9], lam, shm);
            mix::attn_unit(bh >> 3, bh & 7, 15 - s, Qb, Kb, Vb, MIX, args.in[9], lam, shm); }
        SEAM(2);
    }

    if (IN(3)) {
        pg8::Gemm g{MIX, (const bf16*)(ws + WS_WOUT), MROWS, DMODEL, DMODEL}; pg8::StaticOrder S; S.init(MROWS, DMODEL, F.G, (int)blockIdx.x);
        pg8::EpiResSsq E{args.in[0], args.out, XN, args.in[11], ssq1};
        pg8::gemm_phase<pg8::EpiResSsq, pg8::StaticOrder, false, true>(F.lds + RING_OFF, g, S, E);
        SEAM(3);
    }

    if (IN(4)) {
        pg8::Gemm g{XN, (const bf16*)(ws + WS_WGU), MROWS, GUW, DMODEL}; pg8::StaticOrder S; S.init(MROWS, GUW, F.G, (int)blockIdx.x);
        pg8::EpiSwiGlu E{ACT, ssq1};
        pg8::gemm_phase<pg8::EpiSwiGlu, pg8::StaticOrder, true, true>(F.lds + RING_OFF, g, S, E);
        SEAM(4);
    }

    if (IN(5)) {
        pg8::Gemm g{ACT, (const bf16*)(ws + WS_WD), MROWS, DMODEL, FFN}; pg8::StaticOrder S; S.init(MROWS, DMODEL, F.G, (int)blockIdx.x);
        pg8::EpiResSsq E{args.out, args.out, nullptr, nullptr, ssq2};
        pg8::gemm_phase<pg8::EpiResSsq, pg8::StaticOrder, false, true>(F.lds + RING_OFF, g, S, E);
        SEAM(5);
    }

    if (IN(6)) {
        const int gw = F.vcu * NWAVES + F.wave, NGW = F.G * NWAVES;
        for (int m = gw; m < MROWS; m += NGW) final_norm_row(args.out + (size_t)m * DMODEL, ssq2 + (size_t)m * 8, args.in[14], F.lane);
    }
#undef IN
#undef SEAM
}
#if DEBUG_CHECK
__device__ __forceinline__ float dbg_bf(bf16 v) { return __uint_as_float((unsigned)v << 16); }
__device__ __forceinline__ unsigned dbg_hash(unsigned x) { x ^= x >> 16; x *= 0x7feb352dU; x ^= x >> 15; x *= 0x846ca68bU; x ^= x >> 16; return x; }
__device__ __forceinline__ void dbg_rep(unsigned* ctl, int stage, float got, float exp, float a) {
    float e = fabsf(got - exp) / (fabsf(exp) + a); if (!(e == e) || !(e < 1e30f)) e = 1e30f;
    atomicMax(ctl + CW_ERR + stage, __float_as_uint(e));
}
__global__ void dbg_chk0(Args a) {
    unsigned* ctl = (unsigned*)(a.ws + WS_CTL); const int lane = threadIdx.x, i = blockIdx.x; unsigned char* ws = a.ws;
    { const int m = dbg_hash(i * 7 + 1) % MROWS; const float* xr = a.in[0] + (size_t)m * DMODEL; float s = 0.f;
      for (int k = lane; k < DMODEL; k += 64) s += xr[k] * xr[k];
      const float r = 1.0f / sqrtf(wave_sum(s) / DMODEL + NORM_EPS); const bf16* XN = (const bf16*)(ws + WS_XN);
      for (int k = lane; k < DMODEL; k += 64) dbg_rep(ctl, 0, dbg_bf(XN[(size_t)m * DMODEL + k]), xr[k] * r * a.in[1][k], 1e-3f); }
    { const int rho = dbg_hash(i * 7 + 2) % INW, k = (dbg_hash(i * 7 + 3) + 37 * lane) % DMODEL; const int pn = rho >> 8, c = rho & 255;
      const int n = (pn >= 4 && pn < 12) ? 256 * pn + 64 * ((c >> 5) & 3) + 32 * (c >> 7) + (c & 31) : rho;
      dbg_rep(ctl, 1, dbg_bf(((const bf16*)(ws + WS_WIN))[(size_t)rho * DMODEL + k]), a.in[2][(size_t)k * INW + n], 1e-4f); }
    { const int n = dbg_hash(i * 7 + 4) % DMODEL, k = (dbg_hash(i * 7 + 5) + 37 * lane) % DMODEL;
      dbg_rep(ctl, 2, dbg_bf(((const bf16*)(ws + WS_WOUT))[(size_t)n * DMODEL + k]), a.in[10][(size_t)k * DMODEL + n], 1e-4f); }
    { const int rho = dbg_hash(i * 7 + 6) % GUW, k = (dbg_hash(i * 7 + 8) + 37 * lane) % DMODEL; const int n = ((rho >> 7) & 1) * FFN + 128 * (rho >> 8) + (rho & 127);
      dbg_rep(ctl, 3, dbg_bf(((const bf16*)(ws + WS_WGU))[(size_t)rho * DMODEL + k]), a.in[12][(size_t)k * GUW + n], 1e-4f); }
    { const int n = dbg_hash(i * 7 + 9) % DMODEL, k = (dbg_hash(i * 7 + 10) + 37 * lane) % FFN;
      dbg_rep(ctl, 4, dbg_bf(((const bf16*)(ws + WS_WD))[(size_t)n * FFN + k]), a.in[13][(size_t)k * DMODEL + n], 1e-4f); }
    { const int g = i & 3, d = dbg_hash(i * 7 + 11) % 256, c = (dbg_hash(i * 7 + 12) + 37 * lane) % 256;
      dbg_rep(ctl, 5, dbg_bf(((const bf16*)(ws + WS_WPOOL))[(size_t)g * 65536 + d * 256 + c]), a.in[3][(size_t)g * 65536 + c * 256 + d], 1e-4f); }
}
__device__ __forceinline__ float dbg_dot_xn_w(const bf16* arow, const float* W, int K, int N, int n, int lane) {
    float s = 0.f; for (int k = lane; k < K; k += 64) s += dbg_bf(arow[k]) * W[(size_t)k * N + n]; return wave_sum(s);
}
__global__ void dbg_chk1(Args a) {
    unsigned* ctl = (unsigned*)(a.ws + WS_CTL); const int lane = threadIdx.x, i = blockIdx.x; unsigned char* ws = a.ws;
    const int m = dbg_hash(i * 3 + 100) % MROWS; int c = dbg_hash(i * 3 + 101) % INW; if ((i & 3) == 0) c = 1024 + (c & 2047);
    const bf16* xr = (const bf16*)(ws + WS_XN) + (size_t)m * DMODEL; float exp_; bf16 gotb;
    if (c < 1024) { exp_ = dbg_dot_xn_w(xr, a.in[2], DMODEL, INW, c, lane); gotb = ((const bf16*)(ws + WS_U))[(size_t)m * 1024 + c]; }
    else if (c >= 3072) { exp_ = dbg_dot_xn_w(xr, a.in[2], DMODEL, INW, c, lane); gotb = ((const bf16*)(ws + WS_V))[(size_t)m * 1024 + c - 3072]; }
    else { const int j = c & 63, clo = (c & ~63) + (j & 31); const float x1 = dbg_dot_xn_w(xr, a.in[2], DMODEL, INW, clo, lane), x2 = dbg_dot_xn_w(xr, a.in[2], DMODEL, INW, clo + 32, lane);
        const float ang = (float)(m & 2047) * a.inv_freq[j & 31]; const double rev = (double)ang * 0.15915494309189535; const float fr = (float)(rev - __builtin_floor(rev));
        const float sn = __builtin_amdgcn_sinf(fr), cs = __builtin_amdgcn_cosf(fr);
        exp_ = (j < 32) ? x1 * cs - x2 * sn : x1 * sn + x2 * cs;
        if (c < 2048) { exp_ *= QSCALE; gotb = ((const bf16*)(ws + WS_Q))[(size_t)m * 1024 + c - 1024]; } else gotb = ((const bf16*)(ws + WS_K))[(size_t)m * 1024 + c - 2048]; }
    if (lane == 0) dbg_rep(ctl, 6, dbg_bf(gotb), exp_, 0.25f);
}
__global__ void dbg_chk2a(Args a) {
    unsigned* ctl = (unsigned*)(a.ws + WS_CTL); const int lane = threadIdx.x, i = blockIdx.x; unsigned char* ws = a.ws;
    int m = dbg_hash(i * 3 + 200) % MROWS; if ((i & 7) == 0) m = (m & ~2047) + (i >> 3) % 20; const int c = dbg_hash(i * 3 + 201) % 1024; const int g = c >> 8, d = c & 255, w = 2 << g, pos = m & 2047;
    const bf16* U = (const bf16*)(ws + WS_U); float s = 0.f;
    for (int cc = lane; cc < 256; cc += 64) { float ws_ = 0.f; int cnt = 0; for (int j = 0; j < w; ++j) if (pos - j >= 0) { ws_ += dbg_bf(U[(size_t)(m - j) * 1024 + g * 256 + cc]); ++cnt; }
        const float pooled = ws_ / (float)cnt - dbg_bf(U[(size_t)m * 1024 + g * 256 + cc]); s += pooled * a.in[3][(size_t)g * 65536 + cc * 256 + d]; }
    s = wave_sum(s) * a.in[4][c];
    if (lane == 0) dbg_rep(ctl, 7, dbg_bf(((const bf16*)(ws + WS_MIX))[(size_t)m * DMODEL + c]), s, 0.25f);
}
__global__ void dbg_chk2b(Args a) {
    __shared__ float sc[2][2048]; __shared__ float red[4]; __shared__ float od[128];
    unsigned* ctl = (unsigned*)(a.ws + WS_CTL); const int tid = threadIdx.x, lane = tid & 63, wv = tid >> 6, i = blockIdx.x; unsigned char* ws = a.ws;
    int m = dbg_hash(i * 3 + 300) % MROWS; if ((i & 3) == 0) m = (m & ~2047) + (dbg_hash(i) % 200); const int h = dbg_hash(i * 3 + 301) % 8; const int t = m & 2047, b = m >> 11;
    const int kend = ((t >> 6) + 1) * 64;
    const bf16 *Q = (const bf16*)(ws + WS_Q), *K = (const bf16*)(ws + WS_K), *V = (const bf16*)(ws + WS_V);
    const float d1 = wave_sum(a.in[5][lane] * a.in[6][lane]), d2 = wave_sum(a.in[7][lane] * a.in[8][lane]); const float lam = expf(d1) - expf(d2) + 0.2f;
    for (int k = tid; k < kend; k += 128) { float s1 = 0.f, s2 = 0.f; const bf16* qp = Q + (size_t)m * 1024 + h * 128; const bf16* kp = K + (size_t)(b * 2048 + k) * 1024 + h * 128;
        for (int d = 0; d < 64; ++d) { s1 += dbg_bf(qp[d]) * dbg_bf(kp[d]); s2 += dbg_bf(qp[64 + d]) * dbg_bf(kp[64 + d]); }
        sc[0][k] = s1; sc[1][k] = s2; }
    __syncthreads();
    float mx[2], ll[2];
    for (int c = 0; c < 2; ++c) { float v = -1e30f; for (int k = tid; k < kend; k += 128) v = fmaxf(v, sc[c][k]);
        for (int o = 1; o < 64; o <<= 1) v = fmaxf(v, __shfl_xor(v, o)); if (lane == 0) red[wv] = v; __syncthreads(); mx[c] = fmaxf(red[0], red[1]); __syncthreads();
        float s = 0.f; for (int k = tid; k < kend; k += 128) s += exp2f(sc[c][k] - mx[c]); s = wave_sum(s); if (lane == 0) red[wv] = s; __syncthreads(); ll[c] = red[0] + red[1]; __syncthreads(); }
    float o = 0.f; const int d = tid;
    for (int k = 0; k < kend; ++k) { const float av = exp2f(sc[0][k] - mx[0]) / ll[0] - lam * exp2f(sc[1][k] - mx[1]) / ll[1]; o += av * dbg_bf(V[(size_t)(b * 2048 + k) * 1024 + h * 128 + d]); }
    float ss = wave_sum(o * o); if (lane == 0) red[wv] = ss; __syncthreads(); ss = red[0] + red[1];
    const float exp_ = o / sqrtf(ss / 128.f + NORM_EPS) * a.in[9][d] * 0.8f;
    dbg_rep(ctl, 8, dbg_bf(((const bf16*)(ws + WS_MIX))[(size_t)m * DMODEL + 1024 + h * 128 + d]), exp_, 0.25f);
    (void)od;
}
__global__ void dbg_chk3(Args a) {
    unsigned* ctl = (unsigned*)(a.ws + WS_CTL); const int lane = threadIdx.x, i = blockIdx.x; unsigned char* ws = a.ws;
    const int m = dbg_hash(i * 3 + 400) % MROWS, n = dbg_hash(i * 3 + 401) % DMODEL;
    const float x1 = a.in[0][(size_t)m * DMODEL + n] + dbg_dot_xn_w((const bf16*)(ws + WS_MIX) + (size_t)m * DMODEL, a.in[10], DMODEL, DMODEL, n, lane);
    float s = 0.f; for (int k = lane; k < DMODEL; k += 64) { const float v = a.out[(size_t)m * DMODEL + k]; s += v * v; } s = wave_sum(s);
    const float* q = (const float*)(ws + WS_SSQ1) + (size_t)m * 8; float tot = 0.f; for (int j = 0; j < 8; ++j) tot += q[j];
    if (lane == 0) { dbg_rep(ctl, 9, a.out[(size_t)m * DMODEL + n], x1, 0.25f); dbg_rep(ctl, 10, dbg_bf(((const bf16*)(ws + WS_XN))[(size_t)m * DMODEL + n]), x1 * a.in[11][n], 0.25f); dbg_rep(ctl, 11, tot, s, 1.0f); }
}
__global__ void dbg_chk4(Args a) {
    unsigned* ctl = (unsigned*)(a.ws + WS_CTL); const int lane = threadIdx.x, i = blockIdx.x; unsigned char* ws = a.ws;
    const int m = dbg_hash(i * 3 + 500) % MROWS, j = dbg_hash(i * 3 + 501) % FFN;
    float s = 0.f; for (int k = lane; k < DMODEL; k += 64) { const float v = a.out[(size_t)m * DMODEL + k]; s += v * v; } const float r = 1.0f / sqrtf(wave_sum(s) / DMODEL + NORM_EPS);
    const bf16* xr = (const bf16*)(ws + WS_XN) + (size_t)m * DMODEL;
    const float g = r * dbg_dot_xn_w(xr, a.in[12], DMODEL, GUW, j, lane), up = r * dbg_dot_xn_w(xr, a.in[12], DMODEL, GUW, FFN + j, lane);
    if (lane == 0) dbg_rep(ctl, 12, dbg_bf(((const bf16*)(ws + WS_ACT))[(size_t)m * FFN + j]), g / (1.0f + expf(-g)) * up, 0.25f);
}
__global__ void dbg_chk5(Args a) {
    __shared__ float red[4];
    unsigned* ctl = (unsigned*)(a.ws + WS_CTL); const int tid = threadIdx.x, lane = tid & 63, wv = tid >> 6, i = blockIdx.x; unsigned char* ws = a.ws;
    const int m = dbg_hash(i * 3 + 600) % MROWS; float acc[8];
    const bf16* mr = (const bf16*)(ws + WS_MIX) + (size_t)m * DMODEL; const bf16* ar = (const bf16*)(ws + WS_ACT) + (size_t)m * FFN;
    for (int q = 0; q < 8; ++q) acc[q] = a.in[0][(size_t)m * DMODEL + tid + 256 * q];
    for (int k = 0; k < DMODEL; ++k) { const float v = dbg_bf(mr[k]); const float* wr = a.in[10] + (size_t)k * DMODEL + tid;
#pragma unroll
        for (int q = 0; q < 8; ++q) acc[q] += v * wr[256 * q]; }
    for (int k = 0; k < FFN; ++k) { const float v = dbg_bf(ar[k]); const float* wr = a.in[13] + (size_t)k * DMODEL + tid;
#pragma unroll
        for (int q = 0; q < 8; ++q) acc[q] += v * wr[256 * q]; }
    float s = 0.f;
#pragma unroll
    for (int q = 0; q < 8; ++q) s += acc[q] * acc[q];
    s = wave_sum(s); if (lane == 0) red[wv] = s; __syncthreads(); const float r = 1.0f / sqrtf((red[0] + red[1] + red[2] + red[3]) / DMODEL + NORM_EPS);
#pragma unroll
    for (int q = 0; q < 8; ++q) dbg_rep(ctl, 13, a.out[(size_t)m * DMODEL + tid + 256 * q], acc[q] * r * a.in[14][tid + 256 * q], 0.25f);
}
__global__ void dbg_report(Args a) {
    if (threadIdx.x != 0) return; const unsigned* ctl = (const unsigned*)(a.ws + WS_CTL);
    const float tol[14] = {0.006f, 0.005f, 0.005f, 0.005f, 0.005f, 0.005f, 0.03f, 0.03f, 0.05f, 0.03f, 0.03f, 0.001f, 0.05f, 0.03f};
    for (int s = 0; s < 14; ++s) { const float e = __uint_as_float(ctl[CW_ERR + s]); if (e > tol[s]) { a.out[0] = 1000.0f * (float)(s + 1); break; } }
    if (ctl[CW_BAR + XB_TMO] != 0u) a.out[1] = 77777.0f;
}
static void dbg_after_phase(int ph, const Args& a, hipStream_t st) {
    if (ph == 0) hipLaunchKernelGGL(dbg_chk0, dim3(256), dim3(64), 0, st, a);
    if (ph == 1) hipLaunchKernelGGL(dbg_chk1, dim3(2048), dim3(64), 0, st, a);
    if (ph == 2) { hipLaunchKernelGGL(dbg_chk2a, dim3(2048), dim3(64), 0, st, a); hipLaunchKernelGGL(dbg_chk2b, dim3(256), dim3(128), 0, st, a); }
    if (ph == 3) hipLaunchKernelGGL(dbg_chk3, dim3(2048), dim3(64), 0, st, a);
    if (ph == 4) hipLaunchKernelGGL(dbg_chk4, dim3(2048), dim3(64), 0, st, a);
    if (ph == 6) hipLaunchKernelGGL(dbg_chk5, dim3(32), dim3(256), 0, st, a);
}
#endif
extern "C" void kernel_launch(void* const* d_in, const int* in_sizes, int n_in, void* d_out, int out_size, void* d_ws, size_t ws_size, hipStream_t stream) {
    static int grid = 0;
    if (grid == 0) {
        if (n_in != 15 || in_sizes[0] != MROWS * DMODEL || out_size != MROWS * DMODEL || ws_size < WS_END) {
            fprintf(stderr, "kernel_launch: built for 15 inputs, x/out of %d floats, >= %zu bytes of workspace; got n_in %d, in0 %d, out %d, ws %zu; nothing launched\n", MROWS * DMODEL, (size_t)WS_END, n_in, n_in > 0 ? in_sizes[0] : -1, out_size, ws_size); grid = -1; return; }
        int dev = 0, cus = 0, per_cu = 0;
        if (hipGetDevice(&dev) != hipSuccess || hipDeviceGetAttribute(&cus, hipDeviceAttributeMultiprocessorCount, dev) != hipSuccess) { fprintf(stderr, "kernel_launch: device query failed\n"); grid = -1; return; }
        if (hipFuncSetAttribute((const void*)fwd_kernel, hipFuncAttributeMaxDynamicSharedMemorySize, LDS_BYTES) != hipSuccess) { fprintf(stderr, "kernel_launch: hipFuncSetAttribute failed\n"); grid = -1; return; }
        if (hipOccupancyMaxActiveBlocksPerMultiprocessor(&per_cu, (const void*)fwd_kernel, NWAVES * 64, LDS_BYTES) != hipSuccess) per_cu = 0;
        (void)hipGetLastError();
        if (per_cu < 1 || cus * (per_cu < 1 ? 1 : per_cu) < 256) { fprintf(stderr, "kernel_launch: needs 256 co-resident workgroups (CUs %d, per CU %d); nothing launched\n", cus, per_cu); grid = -1; return; }
        grid = 256;
    }
    if (grid < 0) return;
    (void)hipMemsetAsync((char*)d_ws + WS_CTL, 0, CTL_ZERO_BYTES, stream);
    Args a{};
    for (int i = 0; i < 15; ++i) a.in[i] = (const float*)d_in[i];
    a.out = (float*)d_out; a.ws = (unsigned char*)d_ws;
    for (int j = 0; j < 32; ++j) a.inv_freq[j] = powf(10000.0f, -(float)(2 * j) / 64.0f);
#if DEBUG_CHECK
    for (int ph = 0; ph < N_PHASES; ++ph) { a.ph_lo = ph; a.ph_hi = ph + 1; hipLaunchKernelGGL(fwd_kernel, dim3(grid), dim3(NWAVES * 64), LDS_BYTES, stream, a); dbg_after_phase(ph, a, stream); }
    hipLaunchKernelGGL(dbg_report, dim3(1), dim3(64), 0, stream, a);
#else
    constexpr int NL = MK_N_LAUNCHES;
    for (int li = 0; li < NL; ++li) { a.ph_lo = (NL == 1) ? 0 : li; a.ph_hi = (NL == 1) ? N_PHASES : li + 1; hipLaunchKernelGGL(fwd_kernel, dim3(grid), dim3(NWAVES * 64), LDS_BYTES, stream, a); }
#endif
    const hipError_t le = hipPeekAtLastError();
    if (le != hipSuccess) fprintf(stderr, "kernel_launch: launch failed: %s\n", hipGetErrorName(le));
}
```

```cpp
#include <hip/hip_runtime.h>
#include <cstdio>
#include <cstdint>
#ifndef DEBUG_CHECK
#define DEBUG_CHECK 0
#endif
#ifndef MK_N_LAUNCHES
#define MK_N_LAUNCHES 1
#endif
constexpr int BATCH = 4, SEQ = 2048, DMODEL = 2048, MROWS = BATCH * SEQ;
constexpr int POOLW = 1024, QKW = 1024, ATTW = 1024, INW = 4096, NHEAD = 8, HDIM = 64, VDIM = 128;
constexpr int FFN = 5632, GUW = 2 * FFN;
constexpr float NORM_EPS = 1e-6f;
constexpr float QSCALE = 0.125f * 1.4426950408889634f;
namespace pg8 {
#define PG8_LAS __attribute__((address_space(3)))
typedef unsigned short bf16_t;
typedef short bf16x8 __attribute__((ext_vector_type(8)));
typedef float f32x4 __attribute__((ext_vector_type(4)));
typedef unsigned u32x4 __attribute__((ext_vector_type(4)));
constexpr int BM = 256, BK = 64, HALF = 128, HTB = HALF * BK * 2  , STAGE_BYTES = 8 * HTB, NXCD = 8, WGM = 8;

__host__ __device__ __forceinline__ int lds_byte(int r, int c) { const int st = (r >> 4) * 2 + (c >> 5), rr = r & 15, cc = c & 31, ob = rr * 64 + cc * 2; return st * 1024 + (ob ^ (((ob >> 9) & 1) << 5)); }
__host__ __device__ __forceinline__ void stage_rc(int b, int& R, int& C) { const int st = b / 1024, sb = b % 1024, swz = sb ^ (((sb >> 9) & 1) << 5); R = (st >> 1) * 16 + swz / 64; C = (st & 1) * 32 + (swz % 64) / 2; }
__host__ __device__ __forceinline__ int perm32(int rho) { const int n = rho >> 4, i = rho & 15; return 8 * (i >> 2) + 4 * n + (i & 3); }

struct Unit { int pm, pn; };
struct Gemm { const bf16_t* A; const bf16_t* Bt; int M, N, K; };

struct StaticOrder {
    int nM, nN, nwg, G, c;
    __host__ __device__ void init(int M, int N, int G_, int c_) { nM = M / BM; nN = N / BM; nwg = nM * nN; G = G_; c = c_; }
    __host__ __device__ bool next(int i, Unit& u) const {
        const long L = (long)i * G + c; if (L >= nwg) return false;
        int wgid = (int)L; { const int q = nwg / NXCD, r = nwg % NXCD, xcd = wgid % NXCD, off = wgid / NXCD; wgid = (xcd < r ? xcd * (q + 1) : r * (q + 1) + (xcd - r) * q) + off; }
        const int nig = WGM * nN, gid = wgid / nig, fm = gid * WGM, gsz = (nM - fm) < WGM ? (nM - fm) : WGM;
        u.pm = fm + ((wgid % nig) % gsz); u.pn = (wgid % nig) / gsz; return true;
    }
    __device__ __forceinline__ void a_ready(const Unit&) const {}
    __device__ __forceinline__ void done(const Unit&) const {}
};

__device__ __forceinline__ unsigned cvt_pk_bf16(float lo, float hi) { unsigned r; asm volatile("v_cvt_pk_bf16_f32 %0, %1, %2" : "=v"(r) : "v"(lo), "v"(hi)); return r; }
typedef float f32x2 __attribute__((ext_vector_type(2)));
typedef unsigned u32x2 __attribute__((ext_vector_type(2)));
struct EpiInProj {
    static constexpr bool PERM = true, AFTER_DRAIN = false;
    bf16_t *U, *Q; unsigned char* KV; const float* rope;
    __device__ __forceinline__ void operator()(const f32x4 (&acc)[2][2][4][2], const Unit& u, int wr, int wc, int fr, int fq) const {
        const int row0 = u.pm * BM + wr * 64 + fr; const int pn = u.pn, colt = (pn & 3) * BM;
        if (pn < 4) {
            const int col0 = colt + wc * 32 + 8 * fq;
#pragma unroll
            for (int ai = 0; ai < 2; ++ai)
#pragma unroll
                for (int m = 0; m < 4; ++m) { bf16_t* rowp = U + (size_t)(row0 + ai * HALF + m * 16) * 1024 + col0;
#pragma unroll
                    for (int bj = 0; bj < 2; ++bj) { const f32x4 v0 = acc[ai][bj][m][0], v1 = acc[ai][bj][m][1];
                        u32x4 w; w.x = cvt_pk_bf16(v0[0], v0[1]); w.y = cvt_pk_bf16(v0[2], v0[3]); w.z = cvt_pk_bf16(v1[0], v1[1]); w.w = cvt_pk_bf16(v1[2], v1[3]);
                        *(u32x4*)(rowp + bj * HALF) = w; } }
        } else if (pn >= 12) {
#pragma unroll
            for (int ai = 0; ai < 2; ++ai)
#pragma unroll
                for (int m = 0; m < 4; ++m) { const int row = row0 + ai * HALF + m * 16; const int b = row >> 11, pos = row & 2047;
#pragma unroll
                    for (int bj = 0; bj < 2; ++bj) { const f32x4 v0 = acc[ai][bj][m][0], v1 = acc[ai][bj][m][1]; const int h = 2 * (pn - 12) + bj;
                        u32x4 w; w.x = cvt_pk_bf16(v0[0], v0[1]); w.y = cvt_pk_bf16(v0[2], v0[3]); w.z = cvt_pk_bf16(v1[0], v1[1]); w.w = cvt_pk_bf16(v1[2], v1[3]);
                        *(u32x4*)(KV + ((size_t)((b * 8 + h) * 32 + (pos >> 6)) << 15) + 16384 + wc * 4096 + (pos & 63) * 64 + 16 * fq) = w; } }
        } else {
            const float sc = pn < 8 ? QSCALE : 1.0f; const int col0 = colt + 64 * wc + 8 * fq;
#pragma unroll
            for (int ai = 0; ai < 2; ++ai)
#pragma unroll
                for (int m = 0; m < 4; ++m) { const int row = row0 + ai * HALF + m * 16; const int pos = row & 2047;
                    const f32x4* rp = (const f32x4*)(rope + (size_t)pos * 64 + 16 * fq);
                    const f32x4 t0 = rp[0], t1 = rp[1], t2 = rp[2], t3 = rp[3];
                    const float cs[8] = {t0[0], t0[2], t1[0], t1[2], t2[0], t2[2], t3[0], t3[2]}, sn[8] = {t0[1], t0[3], t1[1], t1[3], t2[1], t2[3], t3[1], t3[3]};
                    float o1[8], o2[8];
#pragma unroll
                    for (int i = 0; i < 8; ++i) { const float x1 = acc[ai][0][m][i >> 2][i & 3], x2 = acc[ai][1][m][i >> 2][i & 3];
                        o1[i] = (x1 * cs[i] - x2 * sn[i]) * sc; o2[i] = (x1 * sn[i] + x2 * cs[i]) * sc; }
                    u32x4 w1, w2; w1.x = cvt_pk_bf16(o1[0], o1[1]); w1.y = cvt_pk_bf16(o1[2], o1[3]); w1.z = cvt_pk_bf16(o1[4], o1[5]); w1.w = cvt_pk_bf16(o1[6], o1[7]);
                    w2.x = cvt_pk_bf16(o2[0], o2[1]); w2.y = cvt_pk_bf16(o2[2], o2[3]); w2.z = cvt_pk_bf16(o2[4], o2[5]); w2.w = cvt_pk_bf16(o2[6], o2[7]);
                    if (pn < 8) { bf16_t* rowp = Q + (size_t)row * 1024 + col0; *(u32x4*)(rowp) = w1; *(u32x4*)(rowp + 32) = w2; }
                    else { const int b = row >> 11, h = 2 * (pn - 8) + (wc >> 1);
                        unsigned char* kp = KV + ((size_t)((b * 8 + h) * 32 + (pos >> 6)) << 15) + (wc & 1) * 8192 + fq * 1024 + (pos & 63) * 16;
                        *(u32x4*)(kp) = w1; *(u32x4*)(kp + 4096) = w2; } }
        }
    }
};
struct EpiSwiGlu {
    static constexpr bool PERM = true, AFTER_DRAIN = false;
    bf16_t* act; const float* ssq;
    __device__ __forceinline__ void operator()(const f32x4 (&acc)[2][2][4][2], const Unit& u, int wr, int wc, int fr, int fq) const {
        const int row0 = u.pm * BM + wr * 64 + fr; const int col0 = u.pn * HALF + wc * 32 + 8 * fq;
#pragma unroll
        for (int ai = 0; ai < 2; ++ai)
#pragma unroll
            for (int m = 0; m < 4; ++m) { const int row = row0 + ai * HALF + m * 16;
                const f32x4 sa = *(const f32x4*)(ssq + (size_t)row * 8), sb = *(const f32x4*)(ssq + (size_t)row * 8 + 4);
                const float tot = ((sa[0] + sa[1]) + (sa[2] + sa[3])) + ((sb[0] + sb[1]) + (sb[2] + sb[3]));
                const float r = 1.0f / sqrtf(tot * (1.0f / 2048.0f) + NORM_EPS);
                float o[8];
#pragma unroll
                for (int i = 0; i < 8; ++i) { const float g = acc[ai][0][m][i >> 2][i & 3] * r, up = acc[ai][1][m][i >> 2][i & 3] * r;
                    const float e = __builtin_amdgcn_exp2f(g * -1.4426950408889634f); o[i] = g * __builtin_amdgcn_rcpf(1.0f + e) * up; }
                u32x4 w; w.x = cvt_pk_bf16(o[0], o[1]); w.y = cvt_pk_bf16(o[2], o[3]); w.z = cvt_pk_bf16(o[4], o[5]); w.w = cvt_pk_bf16(o[6], o[7]);
                *(u32x4*)(act + (size_t)row * FFN + col0) = w; }
    }
};
struct EpiResSsq {
    static constexpr bool PERM = false, AFTER_DRAIN = true;
    const float* base; float* out; bf16_t* xb; const float* gain; float* ssq;
    __device__ __forceinline__ void fused(f32x4 (&acc)[2][2][4][2], const Unit& u, int wr, int wc, int fr, int fq, PG8_LAS unsigned char* lds, int wid, int lane) const {
        PG8_LAS float* P = (PG8_LAS float*)lds;
        const int col0 = u.pn * BM + wc * 32 + 4 * fq;
#pragma unroll
        for (int ai = 0; ai < 2; ++ai)
#pragma unroll
            for (int m = 0; m < 4; ++m) { const int r = ai * HALF + wr * 64 + m * 16 + fr; const size_t off = (size_t)(u.pm * BM + r) * DMODEL + col0; float s = 0.f;
#pragma unroll
                for (int bj = 0; bj < 2; ++bj)
#pragma unroll
                    for (int n = 0; n < 2; ++n) { const f32x4 bs = *(const f32x4*)(base + off + bj * HALF + n * 16); const f32x4 v = acc[ai][bj][m][n] + bs;
                        *(f32x4*)(out + off + bj * HALF + n * 16) = v; s += (v[0] * v[0] + v[1] * v[1]) + (v[2] * v[2] + v[3] * v[3]);
                        if (xb) { const f32x4 g = *(const f32x4*)(gain + col0 + bj * HALF + n * 16); u32x2 w; w.x = cvt_pk_bf16(v[0] * g[0], v[1] * g[1]); w.y = cvt_pk_bf16(v[2] * g[2], v[3] * g[3]);
                            *(u32x2*)(xb + off + bj * HALF + n * 16) = w; } }
                s += __shfl_xor(s, 16); s += __shfl_xor(s, 32);
                if (fq == 0) P[r * 4 + wc] = s; }
        asm volatile("s_waitcnt lgkmcnt(0)" ::: "memory"); __builtin_amdgcn_s_barrier(); asm volatile("" ::: "memory");
        const int tid = wid * 64 + lane;
        if (tid < 256) { const f32x4 p = *(const PG8_LAS f32x4*)(P + tid * 4); ssq[(size_t)(u.pm * BM + tid) * 8 + u.pn] = (p[0] + p[1]) + (p[2] + p[3]); }
    }
};

template <class Epi, class Sched, bool ALIGN_EPI = false, bool SP2 = false>
__device__ __forceinline__ void gemm_phase(PG8_LAS unsigned char* lds, const Gemm g, const Sched& S, const Epi& E) {
    const int tid = threadIdx.x, wid = __builtin_amdgcn_readfirstlane(tid >> 6), lane = tid & 63, wr = wid >> 2, wc = wid & 3, fr = lane & 15, fq = lane >> 4;
    const int K = g.K, nt = K / BK;
    unsigned voffA[2], voffB[2];
#pragma unroll
    for (int i = 0; i < 2; ++i) { int R, C; stage_rc(tid * 16 + i * 8192, R, C); const int Rb = Epi::PERM ? ((R & ~31) + perm32(R & 31)) : R;
        voffA[i] = (unsigned)(R * K + C) * 2u; voffB[i] = (unsigned)(Rb * K + C) * 2u; }
    const size_t kstep = (size_t)(BK * 2);
    const size_t hstep = (size_t)HALF * K * 2;
    const size_t tstep = 2 * hstep;
    const unsigned ldsw = (unsigned)wid * 1024u;
    const int aoff = lds_byte(wr * 64 + fr, fq * 8), boff = lds_byte(wc * 32 + fr, fq * 8);
#define PG8_SA(b, h) (((b) * 2 + (h)) * HTB)
#define PG8_SB(b, h) ((4 + (b) * 2 + (h)) * HTB)
#define PG8_STAGE(bufoff, gbase, voff) do { _Pragma("unroll") for (int _i = 0; _i < 2; ++_i) \
        __builtin_amdgcn_global_load_lds((const unsigned*)((const char*)(gbase) + (voff)[_i]), (PG8_LAS unsigned*)(lds + (bufoff) + ldsw + _i * 8192), 16, 0, 0); } while (0)
#define PG8_LDA(dst, b, h) do { _Pragma("unroll") for (int m = 0; m < 4; ++m) _Pragma("unroll") for (int k = 0; k < 2; ++k) dst[m][k] = *(const PG8_LAS bf16x8*)(lds + PG8_SA(b, h) + aoff + m * 2048 + k * 1024); } while (0)
#define PG8_LDB(dst, b, h) do { _Pragma("unroll") for (int n = 0; n < 2; ++n) _Pragma("unroll") for (int k = 0; k < 2; ++k) dst[n][k] = *(const PG8_LAS bf16x8*)(lds + PG8_SB(b, h) + boff + n * 2048 + k * 1024); } while (0)
#define PG8_MMA(ai, bj, At, Bt) do { __builtin_amdgcn_s_setprio(1); _Pragma("unroll") for (int m = 0; m < 4; ++m) _Pragma("unroll") for (int n = 0; n < 2; ++n) _Pragma("unroll") for (int k = 0; k < 2; ++k) \
        acc[ai][bj][m][n] = __builtin_amdgcn_mfma_f32_16x16x32_bf16(Bt[n][k], At[m][k], acc[ai][bj][m][n], 0, 0, 0); __builtin_amdgcn_s_setprio(0); } while (0)
#define PG8_WAIT_V(n) asm volatile("s_waitcnt vmcnt(" #n ")" ::: "memory")
#define PG8_WAIT_L(n) asm volatile("s_waitcnt lgkmcnt(" #n ")" ::: "memory")
#define PG8_BAR __builtin_amdgcn_s_barrier()
#define PG8_SCHED __builtin_amdgcn_sched_barrier(0)
    Unit cur, nxt; int ui = 0;
    if (!S.next(0, cur)) return;
    f32x4 acc[2][2][4][2];
#pragma unroll
    for (int a = 0; a < 2; ++a)
#pragma unroll
        for (int b = 0; b < 2; ++b)
#pragma unroll
            for (int m = 0; m < 4; ++m)
#pragma unroll
                for (int n = 0; n < 2; ++n) acc[a][b][m][n] = (f32x4){0.f, 0.f, 0.f, 0.f};
    bf16x8 At[4][2], B0[2][2], B1[2][2];
    const char* cA = (const char*)g.A + (size_t)cur.pm * tstep; const char* cB = (const char*)g.Bt + (size_t)cur.pn * tstep;
    S.a_ready(cur);
    if constexpr (SP2) {
        PG8_STAGE(PG8_SB(0, 0), cB, voffB); PG8_STAGE(PG8_SB(0, 1), cB + hstep, voffB); PG8_STAGE(PG8_SA(0, 0), cA, voffA); PG8_STAGE(PG8_SA(0, 1), cA + hstep, voffA);
        if (wr == 1) PG8_BAR;
        PG8_WAIT_V(2); PG8_BAR;
        PG8_STAGE(PG8_SB(1, 0), cB + kstep, voffB); PG8_STAGE(PG8_SA(1, 0), cA + kstep, voffA); PG8_STAGE(PG8_SB(1, 1), cB + hstep + kstep, voffB);
        PG8_WAIT_V(6); PG8_BAR;
    } else {
        PG8_STAGE(PG8_SB(0, 0), cB, voffB); PG8_STAGE(PG8_SA(0, 0), cA, voffA); PG8_STAGE(PG8_SB(0, 1), cB + hstep, voffB); PG8_STAGE(PG8_SA(0, 1), cA + hstep, voffA);
        if (wr == 1) PG8_BAR;
        PG8_WAIT_V(4); PG8_BAR;
        PG8_STAGE(PG8_SB(1, 0), cB + kstep, voffB); PG8_STAGE(PG8_SA(1, 0), cA + kstep, voffA); PG8_STAGE(PG8_SB(1, 1), cB + hstep + kstep, voffB);
        PG8_WAIT_V(6); PG8_BAR;
    }
    for (;;) {
        const bool has_next = S.next(ui + 1, nxt);
        const char* nA = has_next ? (const char*)g.A + (size_t)nxt.pm * tstep : cA; const char* nB = has_next ? (const char*)g.Bt + (size_t)nxt.pn * tstep : cB;
        for (int t = 0; t < nt; t += 2) {
            const bool last = (t == nt - 2);
            const char* a1 = cA + (size_t)(t + 1) * kstep;
            const char* a2 = last ? nA : cA + (size_t)(t + 2) * kstep; const char* b2 = last ? nB : cB + (size_t)(t + 2) * kstep;
            const char* a3 = a2 + kstep; const char* b3 = b2 + kstep;
            if (last && has_next) S.a_ready(nxt);
            if constexpr (SP2) {
            PG8_LDB(B0, 0, 0); PG8_LDB(B1, 0, 1); PG8_SCHED; PG8_LDA(At, 0, 0); PG8_STAGE(PG8_SA(1, 1), a1 + hstep, voffA);
            PG8_WAIT_V(8); PG8_WAIT_L(0); PG8_BAR; PG8_MMA(0, 0, At, B0); PG8_MMA(0, 1, At, B1); PG8_BAR; PG8_SCHED;
            PG8_LDA(At, 0, 1); PG8_STAGE(PG8_SB(0, 0), b2, voffB); PG8_STAGE(PG8_SB(0, 1), b2 + hstep, voffB); PG8_STAGE(PG8_SA(0, 0), a2, voffA);
            PG8_WAIT_V(8); PG8_WAIT_L(0); PG8_BAR; PG8_MMA(1, 0, At, B0); PG8_MMA(1, 1, At, B1); PG8_BAR; PG8_SCHED;
            PG8_LDB(B0, 1, 0); PG8_LDB(B1, 1, 1); PG8_SCHED; PG8_LDA(At, 1, 0); PG8_STAGE(PG8_SA(0, 1), a2 + hstep, voffA);
            PG8_WAIT_V(8); PG8_WAIT_L(0); PG8_BAR; PG8_MMA(0, 0, At, B0); PG8_MMA(0, 1, At, B1); PG8_BAR; PG8_SCHED;
            PG8_LDA(At, 1, 1); PG8_STAGE(PG8_SB(1, 0), b3, voffB); PG8_STAGE(PG8_SB(1, 1), b3 + hstep, voffB); PG8_STAGE(PG8_SA(1, 0), a3, voffA);
            PG8_WAIT_V(8); PG8_WAIT_L(0); PG8_BAR; PG8_MMA(1, 0, At, B0); PG8_MMA(1, 1, At, B1); PG8_BAR; PG8_SCHED;
            } else {
            PG8_LDB(B0, 0, 0); PG8_SCHED; PG8_LDA(At, 0, 0); PG8_STAGE(PG8_SA(1, 1), a1 + hstep, voffA);
            PG8_WAIT_L(8); PG8_BAR; PG8_WAIT_L(0); PG8_MMA(0, 0, At, B0); PG8_BAR; PG8_SCHED;
            PG8_LDB(B1, 0, 1); PG8_STAGE(PG8_SB(0, 0), b2, voffB);
            PG8_BAR; PG8_WAIT_L(0); PG8_MMA(0, 1, At, B1); PG8_BAR;
            PG8_LDA(At, 0, 1); PG8_STAGE(PG8_SA(0, 0), a2, voffA);
            PG8_BAR; PG8_WAIT_L(0); PG8_MMA(1, 0, At, B0); PG8_BAR; PG8_SCHED;
            PG8_STAGE(PG8_SB(0, 1), b2 + hstep, voffB);
            PG8_WAIT_V(6); PG8_BAR; PG8_MMA(1, 1, At, B1); PG8_BAR;
            PG8_LDB(B0, 1, 0); PG8_SCHED; PG8_LDA(At, 1, 0); PG8_STAGE(PG8_SA(0, 1), a2 + hstep, voffA);
            PG8_WAIT_L(8); PG8_BAR; PG8_WAIT_L(0); PG8_MMA(0, 0, At, B0); PG8_BAR; PG8_SCHED;
            PG8_LDB(B1, 1, 1); PG8_STAGE(PG8_SB(1, 0), b3, voffB);
            PG8_BAR; PG8_WAIT_L(0); PG8_MMA(0, 1, At, B1); PG8_BAR;
            PG8_LDA(At, 1, 1); PG8_STAGE(PG8_SA(1, 0), a3, voffA);
            PG8_BAR; PG8_WAIT_L(0); PG8_MMA(1, 0, At, B0); PG8_BAR; PG8_SCHED;
            PG8_STAGE(PG8_SB(1, 1), b3 + hstep, voffB);
            PG8_WAIT_V(6); PG8_BAR; PG8_MMA(1, 1, At, B1); PG8_BAR;
            }
        }
        if constexpr (ALIGN_EPI) { if (wr == 0) PG8_BAR; }
        if constexpr (!Epi::AFTER_DRAIN) { E(acc, cur, wr, wc, fr, fq); S.done(cur); }
        if (!has_next) break;
#pragma unroll
        for (int a = 0; a < 2; ++a)
#pragma unroll
            for (int b = 0; b < 2; ++b)
#pragma unroll
                for (int m = 0; m < 4; ++m)
#pragma unroll
                    for (int n = 0; n < 2; ++n) acc[a][b][m][n] = (f32x4){0.f, 0.f, 0.f, 0.f};
        cur = nxt; cA = nA; cB = nB; ++ui;
        if constexpr (ALIGN_EPI) { if (wr == 1) PG8_BAR; }
    }
    PG8_WAIT_V(0);
    if constexpr (!ALIGN_EPI) { if (wr == 0) PG8_BAR; }
    PG8_BAR;
    if constexpr (Epi::AFTER_DRAIN) { E.fused(acc, cur, wr, wc, fr, fq, lds, wid, lane); S.done(cur); }
#undef PG8_SA
#undef PG8_SB
#undef PG8_STAGE
#undef PG8_LDA
#undef PG8_LDB
#undef PG8_MMA
#undef PG8_WAIT_V
#undef PG8_WAIT_L
#undef PG8_BAR
#undef PG8_SCHED
}
}
#define GAS __attribute__((address_space(1)))
#define LAS __attribute__((address_space(3)))
typedef unsigned short bf16;
typedef unsigned v4u __attribute__((ext_vector_type(4)));
typedef float f32x4 __attribute__((ext_vector_type(4)));
typedef short bf16x8 __attribute__((ext_vector_type(8)));
typedef GAS unsigned gu32;
typedef GAS unsigned long long gu64;
#define RLX_AGENT __ATOMIC_RELAXED, __HIP_MEMORY_SCOPE_AGENT
#define LDS_WAIT() asm volatile("s_waitcnt lgkmcnt(0)" ::: "memory")
#define VM_WAIT() asm volatile("s_waitcnt vmcnt(0)" ::: "memory")
__device__ __forceinline__ unsigned long long rt() { return __builtin_amdgcn_s_memrealtime(); }
__device__ __forceinline__ unsigned f2bf(float f) { unsigned u = __builtin_bit_cast(unsigned, f); return (u + 0x7fffu + ((u >> 16) & 1u)) >> 16; }
__device__ __forceinline__ unsigned pk2(float lo, float hi) { return f2bf(lo) | (f2bf(hi) << 16); }

#define XB_TMO      128
#define XB_XCNT(j)  (256  + 64 * (j))
#define XB_XSUB(j)  (1280 + 64 * (j))
#define XB_XGEN(j)  (2304 + 64 * (j))
#define XB_TOP      3328
#define XB_TOPGEN   3392
#define XCD_BAR_WORDS 3456
#define XB_SPIN_CAP (1u << 18)

__device__ __forceinline__ unsigned xb_ld(unsigned* p)              { return __hip_atomic_load(p, __ATOMIC_RELAXED, __HIP_MEMORY_SCOPE_AGENT); }
__device__ __forceinline__ unsigned xb_add(unsigned* p, unsigned v) { return __hip_atomic_fetch_add(p, v, __ATOMIC_RELAXED, __HIP_MEMORY_SCOPE_AGENT); }
__device__ __forceinline__ unsigned xb_xcc_id() { return (unsigned)__builtin_amdgcn_s_getreg((3 << 11) | 20) & 0xFu; }
#define XB_SPIN(cond, bar) do { unsigned _sp = 0; while (cond) { __builtin_amdgcn_s_sleep(1); \
    if ((++_sp & 255u) == 0u) { if (xb_ld(&(bar)[XB_TMO])) break; if (_sp > XB_SPIN_CAP) { atomicAdd(&(bar)[XB_TMO], 1u); break; } } } } while (0)

struct XcdBarrier {
    unsigned* bar; unsigned x;
    volatile LAS unsigned* st;
};

__device__ __forceinline__ XcdBarrier xcd_barrier_post(unsigned* bar, volatile LAS unsigned* st) {
    XcdBarrier b; b.bar = bar; b.x = xb_xcc_id(); b.st = st;
    if (threadIdx.x == 0) (void)xb_add(&bar[XB_XCNT(b.x)], 1u);
    return b;
}
__device__ __forceinline__ void xcd_barrier_complete(unsigned* bar, unsigned x, unsigned& nloc, unsigned& nx) {
    const unsigned G = gridDim.x * gridDim.y * gridDim.z;
    unsigned sum, cnt, mine, sp = 0u;
    for (;;) {
        sum = 0u; cnt = 0u; mine = 0u;
#pragma unroll
        for (unsigned j = 0; j < 16; ++j) { const unsigned c = xb_ld(&bar[XB_XCNT(j)]); sum += c; cnt += (c > 0u) ? 1u : 0u; mine = (j == x) ? c : mine; }
        if (sum == G) break;
        __builtin_amdgcn_s_sleep(1);
        if ((++sp & 255u) == 0u) { if (xb_ld(&bar[XB_TMO])) break; if (sp > XB_SPIN_CAP) { atomicAdd(&bar[XB_TMO], 1u); break; } }
    }
    nloc = mine > 0u ? mine : 1u; nx = cnt > 0u ? cnt : 1u;
}

__device__ __forceinline__ void xcd_barrier(const XcdBarrier& b) {
    asm volatile("s_waitcnt vmcnt(0)" ::: "memory");
    __syncthreads();
    if (threadIdx.x == 0) {
        unsigned* bar = b.bar;
        __builtin_amdgcn_s_waitcnt(0);
        unsigned nloc = b.st[0], nx = b.st[1];
        if (nloc == 0u) { xcd_barrier_complete(bar, b.x, nloc, nx); b.st[0] = nloc; b.st[1] = nx; }
        const unsigned old = xb_add(&bar[XB_XSUB(b.x)], 1u);
        const unsigned gen = old / nloc;
        if (old + 1u == (gen + 1u) * nloc) {
            __builtin_amdgcn_fence(__ATOMIC_RELEASE, "agent");
            asm volatile("s_waitcnt vmcnt(0)" ::: "memory");
            const unsigned og = xb_add(&bar[XB_TOP], 1u);
            const unsigned tg = og / nx;
            if (og + 1u == (tg + 1u) * nx) xb_add(&bar[XB_TOPGEN], 1u);
            else XB_SPIN(xb_ld(&bar[XB_TOPGEN]) == tg, bar);
            __builtin_amdgcn_fence(__ATOMIC_ACQUIRE, "agent");
            xb_add(&bar[XB_XGEN(b.x)], 1u);
            asm volatile("s_waitcnt vmcnt(0)" ::: "memory");
        } else {
            XB_SPIN(xb_ld(&bar[XB_XGEN(b.x)]) == gen, bar);
            __builtin_amdgcn_fence(__ATOMIC_ACQUIRE, "agent");
            asm volatile("s_waitcnt vmcnt(0)" ::: "memory");
        }
    }
    __syncthreads();
}
namespace mix {
typedef short bf16x8 __attribute__((ext_vector_type(8)));
typedef short s16x4 __attribute__((ext_vector_type(4)));
typedef short v4i16_t __attribute__((ext_vector_type(4)));
typedef float f32x16 __attribute__((ext_vector_type(16)));
typedef float f32x4 __attribute__((ext_vector_type(4)));
typedef unsigned u32x4 __attribute__((ext_vector_type(4)));
typedef unsigned u32x2 __attribute__((ext_vector_type(2)));
typedef unsigned short bf16;
typedef __attribute__((address_space(3))) const char* lds_cptr;
typedef __attribute__((address_space(3))) char* lds_ptr;
constexpr int PITCH = 1024;
constexpr int SLOT = 32768, NSLOT = 3, LDS_WS = NSLOT * SLOT, ATTN_LDS_BYTES = LDS_WS + 8 * 256;
constexpr int POOL_ROW_B = 528, POOL_LDS_BYTES = 128 * POOL_ROW_B;
constexpr float THR = 8.0f;
__device__ __forceinline__ int crow(int r, int hi) { return (r & 3) + 8 * (r >> 2) + 4 * hi; }
typedef float f32x2_t __attribute__((ext_vector_type(2))); typedef __bf16 bf16x2_t __attribute__((ext_vector_type(2)));
__device__ __forceinline__ unsigned cvtpk(float lo, float hi) { f32x2_t v = {lo, hi}; bf16x2_t b = __builtin_convertvector(v, bf16x2_t); return __builtin_bit_cast(unsigned, b); }
__device__ __forceinline__ float max3f(float a, float b, float c) { float r; asm("v_max3_f32 %0, %1, %2, %3" : "=v"(r) : "v"(a), "v"(b), "v"(c)); return r; }
__device__ __forceinline__ float max2f(float a, float b) { float r; asm("v_max_f32_e32 %0, %1, %2" : "=v"(r) : "v"(a), "v"(b)); return r; }
__device__ __forceinline__ float bf2f(unsigned short v) { return __uint_as_float((unsigned)v << 16); }
__device__ __forceinline__ void glds16(const void* gsrc, unsigned lds_dst) { unsigned keep;
    asm volatile("s_mov_b32 %0, m0\n\ts_mov_b32 m0, %2\n\ts_nop 0\n\tglobal_load_lds_dwordx4 %1, off\n\ts_mov_b32 m0, %0" : "=&s"(keep) : "v"(gsrc), "s"(lds_dst) : "memory"); }
__device__ __forceinline__ s16x4 vtr(lds_cptr p) { return __builtin_bit_cast(s16x4, __builtin_amdgcn_ds_read_tr16_b64_v4i16((__attribute__((address_space(3))) v4i16_t*)p)); }
#define MIX_MFMA32(a, b, c) __builtin_amdgcn_mfma_f32_32x32x16_bf16(a, b, c, 0, 0, 0)
#define MIX_MFMA16(a, b, c) __builtin_amdgcn_mfma_f32_16x16x32_bf16(a, b, c, 0, 0, 0)

template <int W> __device__ __forceinline__ void pool_elem(int rb, int g, const bf16* __restrict__ U, lds_ptr shm) {
    const int tid = threadIdx.x; const int ch8 = tid & 31, slab = tid >> 5; const int r0 = rb * 128 + slab * 8; const int pos0 = r0 & (SEQ - 1);
    const bf16* up = U + (size_t)r0 * PITCH + g * 256 + ch8 * 8;
    u32x4 rows[W + 7];
#pragma unroll
    for (int j = 0; j < W + 7; ++j) { const int rel = j - (W - 1); const int relc = rel < -pos0 ? -pos0 : rel; const u32x4 v = *(const u32x4*)(up + (long)relc * PITCH);
        const bool ok = pos0 + rel >= 0; rows[j] = (u32x4){ok ? v[0] : 0u, ok ? v[1] : 0u, ok ? v[2] : 0u, ok ? v[3] : 0u}; }
#pragma unroll
    for (int rr = 0; rr < 8; ++rr) { const int pos = pos0 + rr; float s[8];
#pragma unroll
        for (int i = 0; i < 8; ++i) s[i] = 0.f;
#pragma unroll
        for (int j = 0; j < W; ++j) { const u32x4 v = rows[rr + j];
#pragma unroll
            for (int i = 0; i < 4; ++i) { s[2 * i] += __uint_as_float(v[i] << 16); s[2 * i + 1] += __uint_as_float(v[i] & 0xffff0000u); } }
        const u32x4 c = rows[rr + W - 1]; const float inv = 1.0f / (float)(pos + 1 < W ? pos + 1 : W);
        u32x4 pk;
#pragma unroll
        for (int i = 0; i < 4; ++i) pk[i] = cvtpk(s[2 * i] * inv - __uint_as_float(c[i] << 16), s[2 * i + 1] * inv - __uint_as_float(c[i] & 0xffff0000u));
        *(__attribute__((address_space(3))) u32x4*)(shm + (slab * 8 + rr) * POOL_ROW_B + ch8 * 16) = pk; }
}
template <int PM> __device__ __forceinline__ void pool_unit(int rb, int g, const bf16* __restrict__ U, const bf16* __restrict__ Wt, const float* __restrict__ pscale, bf16* MIX, lds_ptr shm) {
    const int tid = threadIdx.x, lane = tid & 63, wid = __builtin_amdgcn_readfirstlane(tid >> 6);
    const int fr = lane & 15, fq = lane >> 4;
    const bf16* wp = Wt + (size_t)g * 65536 + (size_t)(wid * 32 + fr) * 256 + fq * 8;
    bf16x8 wf[8][2];
#pragma unroll
    for (int kk = 0; kk < 4; ++kk)
#pragma unroll
        for (int nt = 0; nt < 2; ++nt) wf[kk][nt] = (PM & 8) ? (bf16x8){(short)kk, (short)nt, 0, 0, 0, 0, 0, (short)lane} : *(const bf16x8*)(wp + nt * 16 * 256 + kk * 32);
    if (!(PM & 1)) { if (g == 0) pool_elem<2>(rb, g, U, shm); else if (g == 1) pool_elem<4>(rb, g, U, shm); else if (g == 2) pool_elem<8>(rb, g, U, shm); else pool_elem<16>(rb, g, U, shm); }
#pragma unroll
    for (int kk = 4; kk < 8; ++kk)
#pragma unroll
        for (int nt = 0; nt < 2; ++nt) wf[kk][nt] = (PM & 8) ? (bf16x8){(short)kk, (short)nt, 0, 0, 0, 0, 0, (short)lane} : *(const bf16x8*)(wp + nt * 16 * 256 + kk * 32);
    asm volatile("s_waitcnt lgkmcnt(0)\n\ts_barrier" ::: "memory");
    if (!(PM & 2)) {
        f32x4 acc[2][8];
#pragma unroll
        for (int a = 0; a < 2; ++a)
#pragma unroll
            for (int b = 0; b < 8; ++b) acc[a][b] = (f32x4){0.f, 0.f, 0.f, 0.f};
        const lds_cptr ap = (lds_cptr)shm + fr * POOL_ROW_B + fq * 16;
#pragma unroll
        for (int kk = 0; kk < 8; ++kk) { bf16x8 pf[8];
#pragma unroll
            for (int mt = 0; mt < 8; ++mt) pf[mt] = *(const __attribute__((address_space(3))) bf16x8*)(ap + mt * 16 * POOL_ROW_B + kk * 64);
#pragma unroll
            for (int nt = 0; nt < 2; ++nt)
#pragma unroll
                for (int mt = 0; mt < 8; ++mt) acc[nt][mt] = MIX_MFMA16(wf[kk][nt], pf[mt], acc[nt][mt]); }
        asm volatile("s_waitcnt lgkmcnt(0)\n\ts_barrier" ::: "memory");
#pragma unroll
        for (int nt = 0; nt < 2; ++nt) { const int nl = wid * 32 + nt * 16 + fq * 4; const f32x4 sc = *(const f32x4*)(pscale + g * 256 + nl);
#pragma unroll
            for (int mt = 0; mt < 8; ++mt) { const f32x4 v = acc[nt][mt] * sc; u32x2 o; o.x = cvtpk(v[0], v[1]); o.y = cvtpk(v[2], v[3]);
                *(__attribute__((address_space(3))) u32x2*)(shm + (mt * 16 + fr) * POOL_ROW_B + nl * 2) = o; } }
        asm volatile("s_waitcnt lgkmcnt(0)\n\ts_barrier" ::: "memory");
#pragma unroll
        for (int i = 0; i < 8; ++i) { const int row = i * 16 + (tid >> 5), ch = tid & 31; const u32x4 v = *(const __attribute__((address_space(3))) u32x4*)(shm + row * POOL_ROW_B + ch * 16);
            if (PM & 4) { asm volatile("" :: "v"(v)); } else *(u32x4*)(MIX + (size_t)(rb * 128 + row) * DMODEL + g * 256 + ch * 8) = v; }
    }
    asm volatile("s_waitcnt lgkmcnt(0)\n\ts_barrier" ::: "memory");
}

template <int MODE> __device__ __forceinline__ void attn_unit(int b, int h, int qi, const bf16* Q, const unsigned char* __restrict__ KV, bf16* MIX, const float* __restrict__ gain, float lam, lds_ptr shm) {
    const int tid = threadIdx.x, lane = tid & 63, r32 = lane & 31, hi = lane >> 5; const int wid = __builtin_amdgcn_readfirstlane(tid >> 6);
    const int comp = wid >> 2, rg = wid & 3;
    const long rowbase = (long)b * SEQ; const int q0 = qi * 128;
    const int NT = 2 * qi + 2, cw = 2 * qi + (rg >> 1);
    const bf16* Qw = Q + (rowbase + q0 + rg * 32) * PITCH + h * 128 + comp * 64;
    const unsigned lds0 = (unsigned)(uintptr_t)shm;
    __attribute__((address_space(3))) float* wsf = (__attribute__((address_space(3))) float*)(shm + LDS_WS) + wid * 64;
    const unsigned char* tsrc = KV + ((size_t)((b * 8 + h) * 32) << 15) + wid * 1024 + lane * 16;
    const unsigned tdst = lds0 + wid * 1024;
#define MIX_DMA(t, slot) do { if (!(MODE & 1)) { const unsigned char* s_ = tsrc + ((size_t)(t) << 15); const unsigned d_ = (unsigned)__builtin_amdgcn_readfirstlane(tdst + (slot)); \
        glds16(s_, d_); glds16(s_ + 8192, d_ + 8192); glds16(s_ + 16384, d_ + 16384); glds16(s_ + 24576, d_ + 24576); } } while (0)
#define MIX_BAR() asm volatile("s_waitcnt lgkmcnt(0)\n\ts_barrier" ::: "memory")
    bf16x8 qr[4];
#pragma unroll
    for (int d0 = 0; d0 < 4; ++d0) qr[d0] = *(const bf16x8*)(Qw + (long)r32 * PITCH + d0 * 16 + hi * 8);
    asm volatile("s_waitcnt vmcnt(0)" : "+v"(qr[0]), "+v"(qr[1]), "+v"(qr[2]), "+v"(qr[3]) :: "memory");
    MIX_DMA(0, 0); MIX_DMA(1, SLOT);
    asm volatile("s_waitcnt vmcnt(4) lgkmcnt(0)\n\ts_barrier" ::: "memory");
    float mhat = -1.0e30f, l = 0.f; f32x16 o[4], negm; bf16x8 pw[4];
#pragma unroll
    for (int d0 = 0; d0 < 4; ++d0) { pw[d0] = (bf16x8){0, 0, 0, 0, 0, 0, 0, 0};
#pragma unroll
        for (int r = 0; r < 16; ++r) o[d0][r] = 0.f; }
#pragma unroll
    for (int r = 0; r < 16; ++r) negm[r] = 0.f;
    bool first = true;
    const lds_cptr kb0 = (lds_cptr)shm + comp * 8192 + hi * 1024 + r32 * 16;
    const lds_cptr vb0 = (lds_cptr)shm + 16384 + ((lane >> 4) & 1) * 32 + (lane & 3) * 8 + (4 * hi + ((lane & 15) >> 2)) * 64;
#define MIX_L(slot) do { if (!(MODE & 2)) { \
        f32x16 p0, p1; const lds_cptr kb = kb0 + (slot); bf16x8 kf[8]; \
        _Pragma("unroll") for (int d0 = 0; d0 < 4; ++d0) { kf[2 * d0] = *(const __attribute__((address_space(3))) bf16x8*)(kb + d0 * 2048); kf[2 * d0 + 1] = *(const __attribute__((address_space(3))) bf16x8*)(kb + d0 * 2048 + 512); } \
        __builtin_amdgcn_sched_barrier(0);                                \
        p0 = MIX_MFMA32(kf[0], qr[0], negm); p1 = MIX_MFMA32(kf[1], qr[0], negm); \
        _Pragma("unroll") for (int d0 = 1; d0 < 4; ++d0) { p0 = MIX_MFMA32(kf[2 * d0], qr[d0], p0); p1 = MIX_MFMA32(kf[2 * d0 + 1], qr[d0], p1); } \
        asm volatile("s_nop 15\n\ts_nop 7" : "+v"(p0), "+v"(p1));         \
        float ra = max3f(p0[0], p0[1], p1[0]), rb_ = max3f(p0[2], p0[3], p1[1]); ra = max3f(ra, p1[2], p1[3]); \
        _Pragma("unroll") for (int r = 4; r < 16; r += 4) { ra = max3f(ra, p0[r], p0[r + 1]); rb_ = max3f(rb_, p0[r + 2], p0[r + 3]); ra = max3f(ra, p1[r], p1[r + 1]); rb_ = max3f(rb_, p1[r + 2], p1[r + 3]); } \
        float rm = max2f(ra, rb_); { auto rr_ = __builtin_amdgcn_permlane32_swap(__float_as_uint(rm), __float_as_uint(rm), false, false); rm = max2f(__uint_as_float(rr_[0]), __uint_as_float(rr_[1])); } \
        if (__builtin_expect(__any(first || rm > THR), 0)) { \
            const float dl = first ? rm : fmaxf(rm, 0.f); const float f = first ? 0.f : __builtin_amdgcn_exp2f(-dl); mhat = first ? dl : mhat + dl; first = false; l *= f; \
            _Pragma("unroll") for (int r = 0; r < 16; ++r) { p0[r] -= dl; p1[r] -= dl; } \
            _Pragma("unroll") for (int r = 0; r < 16; ++r) negm[r] = -mhat; \
            if (hi == 0) wsf[r32] = f; \
            _Pragma("unroll") for (int r = 0; r < 16; ++r) { const float fr_ = wsf[crow(r, hi)]; \
                _Pragma("unroll") for (int d0 = 0; d0 < 4; ++d0) o[d0][r] *= fr_; } \
        } \
        float sa = 0.f, sb = 0.f; \
        _Pragma("unroll") for (int r = 0; r < 16; ++r) { p0[r] = __builtin_amdgcn_exp2f(p0[r]); p1[r] = __builtin_amdgcn_exp2f(p1[r]); sa += p0[r]; sb += p1[r]; } \
        l += sa + sb; \
        { u32x4 w0 = {cvtpk(p0[0], p0[1]), cvtpk(p0[2], p0[3]), cvtpk(p0[4], p0[5]), cvtpk(p0[6], p0[7])}, w1 = {cvtpk(p0[8], p0[9]), cvtpk(p0[10], p0[11]), cvtpk(p0[12], p0[13]), cvtpk(p0[14], p0[15])}; \
          u32x4 w2 = {cvtpk(p1[0], p1[1]), cvtpk(p1[2], p1[3]), cvtpk(p1[4], p1[5]), cvtpk(p1[6], p1[7])}, w3 = {cvtpk(p1[8], p1[9]), cvtpk(p1[10], p1[11]), cvtpk(p1[12], p1[13]), cvtpk(p1[14], p1[15])}; \
          pw[0] = __builtin_bit_cast(bf16x8, w0); pw[1] = __builtin_bit_cast(bf16x8, w1); pw[2] = __builtin_bit_cast(bf16x8, w2); pw[3] = __builtin_bit_cast(bf16x8, w3); } \
        if (MODE & 4) { asm volatile("" :: "v"(pw[0]), "v"(pw[1]), "v"(pw[2]), "v"(pw[3])); } \
    } } while (0)
#define MIX_H(slot) do { if (!(MODE & 4)) { const lds_cptr vb = vb0 + (slot); s16x4 vl[16], vh[16]; \
        _Pragma("unroll") for (int i = 0; i < 16; ++i) { vl[i] = vtr(vb + (i >> 2) * 4096 + (i & 3) * 1024); vh[i] = vtr(vb + (i >> 2) * 4096 + (i & 3) * 1024 + 512); } \
        __builtin_amdgcn_sched_barrier(0);                                \
        __builtin_amdgcn_s_setprio(1); \
        _Pragma("unroll") for (int i = 0; i < 16; ++i) { const bf16x8 vf = (bf16x8){vl[i][0], vl[i][1], vl[i][2], vl[i][3], vh[i][0], vh[i][1], vh[i][2], vh[i][3]}; \
            o[i >> 2] = MIX_MFMA32(pw[i & 3], vf, o[i >> 2]); } \
        __builtin_amdgcn_s_setprio(0); } } while (0)
#define MIX_ODD_WAIT(t) do { if ((t) + 2 < NT) asm volatile("s_waitcnt vmcnt(4)" ::: "memory"); else asm volatile("s_waitcnt vmcnt(0)" ::: "memory"); } while (0)
    int slot = 0, slot_dma = 2 * SLOT;
    if (comp == 0) {
        for (int t = 0; t < NT; ++t) {
            if (t <= cw) MIX_L(slot);
            MIX_BAR();
            if (t + 2 < NT) { MIX_DMA(t + 2, slot_dma); slot_dma = (slot_dma == 2 * SLOT) ? 0 : slot_dma + SLOT; }
            if (t <= cw) MIX_H(slot);
            MIX_ODD_WAIT(t); MIX_BAR();
            slot = (slot == 2 * SLOT) ? 0 : slot + SLOT;
        }
        MIX_BAR();
    } else {
        MIX_BAR();
        for (int t = 0; t < NT; ++t) {
            if (t + 2 < NT) { MIX_DMA(t + 2, slot_dma); slot_dma = (slot_dma == 2 * SLOT) ? 0 : slot_dma + SLOT; }
            if (t <= cw) MIX_L(slot);
            MIX_ODD_WAIT(t); MIX_BAR();
            if (t <= cw) MIX_H(slot);
            MIX_BAR();
            slot = (slot == 2 * SLOT) ? 0 : slot + SLOT;
        }
    }
#undef MIX_DMA
#undef MIX_L
#undef MIX_H
#undef MIX_ODD_WAIT
    { auto rr_ = __builtin_amdgcn_permlane32_swap(__float_as_uint(l), __float_as_uint(l), false, false); l = __uint_as_float(rr_[0]) + __uint_as_float(rr_[1]); }
    if (hi == 0) wsf[32 + r32] = 1.0f / l;
    float rli[16];
#pragma unroll
    for (int r = 0; r < 16; ++r) rli[r] = wsf[32 + crow(r, hi)];
    __attribute__((address_space(3))) float* X = (__attribute__((address_space(3))) float*)shm + rg * 4224;
    if (comp == 1) {
#pragma unroll
        for (int d0 = 0; d0 < 4; ++d0)
#pragma unroll
            for (int r = 0; r < 16; ++r) X[crow(r, hi) * 132 + d0 * 32 + r32] = o[d0][r] * rli[r] * lam;
    }
    MIX_BAR();
    if (comp == 0) {
#pragma unroll
        for (int d0 = 0; d0 < 4; ++d0)
#pragma unroll
            for (int r = 0; r < 16; ++r) { const int idx = crow(r, hi) * 132 + d0 * 32 + r32; X[idx] = o[d0][r] * rli[r] - X[idx]; }
        const int row = lane >> 1, half = lane & 1;
        const __attribute__((address_space(3))) f32x4* xr = (const __attribute__((address_space(3))) f32x4*)(X + row * 132 + half * 64);
        float ss = 0.f;
#pragma unroll
        for (int j = 0; j < 16; ++j) { const f32x4 v = xr[j]; ss += (v[0] * v[0] + v[1] * v[1]) + (v[2] * v[2] + v[3] * v[3]); }
        ss += __shfl_xor(ss, 1);
        if (half == 0) wsf[row] = 0.8f / sqrtf(ss * (1.0f / 128.0f) + NORM_EPS);
        const int ch = lane & 15, r4 = lane >> 4;
        const f32x4 g0 = *(const f32x4*)(gain + 8 * ch), g1 = *(const f32x4*)(gain + 8 * ch + 4);
        bf16* op = MIX + (size_t)(rowbase + q0 + rg * 32 + r4) * DMODEL + 1024 + h * 128 + 8 * ch;
#pragma unroll
        for (int j = 0; j < 8; ++j) { const int rw = 4 * j + r4; const float rn = wsf[rw];
            const f32x4 a = *(const __attribute__((address_space(3))) f32x4*)(X + rw * 132 + 8 * ch) * g0 * rn, c = *(const __attribute__((address_space(3))) f32x4*)(X + rw * 132 + 8 * ch + 4) * g1 * rn;
            u32x4 w; w.x = cvtpk(a[0], a[1]); w.y = cvtpk(a[2], a[3]); w.z = cvtpk(c[0], c[1]); w.w = cvtpk(c[2], c[3]); *(u32x4*)(op + (size_t)(4 * j) * DMODEL) = w; }
    }
    MIX_BAR();
#undef MIX_BAR
}
}

constexpr size_t MiB = 1u << 20;
constexpr size_t WS_CTL = 0, CTL_ZERO_BYTES = 1 * MiB;
constexpr size_t WS_ROPE = 1 * MiB;
constexpr size_t WS_SSQ1 = 1 * MiB + 512 * 1024, WS_SSQ2 = WS_SSQ1 + 256 * 1024;
constexpr size_t WS_WPOOL = 2 * MiB;
constexpr size_t WS_WIN = 3 * MiB, WS_WOUT = 19 * MiB, WS_WGU = 27 * MiB, WS_WD = 71 * MiB;
constexpr size_t WS_XN = 93 * MiB;
constexpr size_t WS_U = 125 * MiB, WS_Q = 141 * MiB, WS_K = 157 * MiB, WS_V = 173 * MiB;
constexpr size_t WS_MIX = 189 * MiB;
constexpr size_t WS_ACT = 221 * MiB;
constexpr size_t WS_END = 309 * MiB;
static_assert(WS_ACT + (size_t)MROWS * FFN * 2 == WS_END && WS_WD + (size_t)DMODEL * FFN * 2 == WS_XN && WS_WGU + (size_t)GUW * DMODEL * 2 == WS_WD, "d_ws map");
constexpr int CW_TMO = 0, CW_CODE = 1, CW_ERR = 64, CW_BAR = 4096;
constexpr int RING_OFF = 0, RING_BYTES = 131072;
constexpr int LDSCTL_OFF = RING_BYTES, MISC_OFF = LDSCTL_OFF + 320;
constexpr int LDS_BYTES = 147456;
static_assert(mix::ATTN_LDS_BYTES <= RING_BYTES && mix::POOL_LDS_BYTES <= RING_BYTES, "P2 bodies fit the ring region");
constexpr int NWAVES = 8, N_PHASES = 7;

struct Frame {
    LAS unsigned char* lds; volatile LAS unsigned* MISC; gu32* ctl;
    int tid, lane, wave, vcu, G;
};
__device__ __forceinline__ float wave_sum(float v) {
#pragma unroll
    for (int o = 1; o < 64; o <<= 1) v += __shfl_xor(v, o);
    return v;
}
__device__ __forceinline__ unsigned pk_rne(float lo, float hi) { unsigned r; asm volatile("v_cvt_pk_bf16_f32 %0, %1, %2" : "=v"(r) : "v"(lo), "v"(hi)); return r; }
__device__ __forceinline__ void p0_transpose_item(const float* __restrict__ W, int K, int N, bf16* WT, int k0, int n0, int drow0, LAS float* scr, int lane) {
#pragma unroll 8
    for (int i = 0; i < 32; ++i) { const int kk = 2 * i + (lane >> 5); scr[kk * 33 + (lane & 31)] = W[(size_t)(k0 + kk) * N + n0 + (lane & 31)]; }
    LDS_WAIT(); asm volatile("" ::: "memory");
    const int c = lane & 7;
#pragma unroll
    for (int j = 0; j < 4; ++j) { const int n = (lane >> 3) + 8 * j; const LAS float* s = scr + (8 * c) * 33 + n;
        v4u o; o.x = pk_rne(s[0 * 33], s[1 * 33]); o.y = pk_rne(s[2 * 33], s[3 * 33]); o.z = pk_rne(s[4 * 33], s[5 * 33]); o.w = pk_rne(s[6 * 33], s[7 * 33]);
        *(GAS v4u*)(WT + (size_t)(drow0 + n) * K + k0 + 8 * c) = o; }
    LDS_WAIT(); asm volatile("" ::: "memory");
}
__device__ __forceinline__ void rms_row_to_bf16(const float* xrow, const float* gain, bf16* orow, int lane) {
    const GAS f32x4* xr = (const GAS f32x4*)xrow + lane; const GAS f32x4* gr = (const GAS f32x4*)gain + lane;
    f32x4 v[8]; float s = 0.f;
#pragma unroll
    for (int j = 0; j < 8; ++j) { v[j] = xr[64 * j]; s += (v[j].x * v[j].x + v[j].y * v[j].y) + (v[j].z * v[j].z + v[j].w * v[j].w); }
    const float r = 1.0f / sqrtf(wave_sum(s) * (1.0f / DMODEL) + NORM_EPS);
    GAS unsigned long long* o8 = (GAS unsigned long long*)orow + lane;
#pragma unroll
    for (int j = 0; j < 8; ++j) { const f32x4 g = gr[64 * j]; o8[64 * j] = (unsigned long long)pk_rne(v[j].x * r * g.x, v[j].y * r * g.y) | ((unsigned long long)pk_rne(v[j].z * r * g.z, v[j].w * r * g.w) << 32); }
}
__device__ __forceinline__ void final_norm_row(float* row, const float* ssq8, const float* gain, int lane) {
    const f32x4 sa = *(const GAS f32x4*)ssq8, sb = *((const GAS f32x4*)ssq8 + 1);
    const float tot = ((sa.x + sa.y) + (sa.z + sa.w)) + ((sb.x + sb.y) + (sb.z + sb.w));
    const float r = 1.0f / sqrtf(tot * (1.0f / DMODEL) + NORM_EPS);
    GAS f32x4* xr = (GAS f32x4*)row + lane; const GAS f32x4* gr = (const GAS f32x4*)gain + lane;
#pragma unroll
    for (int j = 0; j < 8; ++j) { const f32x4 v = xr[64 * j], g = gr[64 * j]; xr[64 * j] = v * g * r; }
}
struct Args { const float* in[15]; float* out; unsigned char* ws; float inv_freq[32]; int ph_lo, ph_hi; };

__device__ __forceinline__ void p0_prologue(Frame& F, const Args& a) {
    LAS float* scr = (LAS float*)(F.lds + RING_OFF + F.wave * 16384);
    const int gw = F.vcu * NWAVES + F.wave, NGW = F.G * NWAVES;
    unsigned char* ws = a.ws;
    const float *w_in = a.in[2], *w_pool = a.in[3], *w_out = a.in[10], *w_gu = a.in[12], *w_d = a.in[13];
    bf16 *Win = (bf16*)(ws + WS_WIN), *Wout = (bf16*)(ws + WS_WOUT), *Wgu = (bf16*)(ws + WS_WGU), *Wd = (bf16*)(ws + WS_WD), *Wp = (bf16*)(ws + WS_WPOOL);
    constexpr int I_IN = (DMODEL / 64) * (INW / 32), I_OUT = (DMODEL / 64) * (DMODEL / 32), I_GU = (DMODEL / 64) * (GUW / 32), I_D = (FFN / 64) * (DMODEL / 32), I_P = 4 * (256 / 64) * (256 / 32);
    constexpr int NITEMS = I_IN + I_OUT + I_GU + I_D + I_P;
    for (int it = gw; it < NITEMS; it += NGW) {
        int r = it;
        if (r < I_GU) { const int nblk = GUW / 32, kb = r / nblk, nb = r % nblk, n0 = 32 * nb; const int bj = n0 >= FFN ? 1 : 0, j0 = n0 - bj * FFN;
            p0_transpose_item(w_gu, DMODEL, GUW, Wgu, 64 * kb, n0, 256 * (j0 >> 7) + 128 * bj + (j0 & 127), scr, F.lane); continue; } r -= I_GU;
        if (r < I_D) { const int nblk = DMODEL / 32, kb = r / nblk, nb = r % nblk; p0_transpose_item(w_d, FFN, DMODEL, Wd, 64 * kb, 32 * nb, 32 * nb, scr, F.lane); continue; } r -= I_D;
        if (r < I_IN) { const int nblk = INW / 32, kb = r / nblk, nb = r % nblk, n0 = 32 * nb; int dr = n0;
            if (n0 >= 1024 && n0 < 3072) dr = (n0 & ~255) + 128 * ((n0 >> 5) & 1) + 32 * ((n0 >> 6) & 3);
            p0_transpose_item(w_in, DMODEL, INW, Win, 64 * kb, n0, dr, scr, F.lane); continue; } r -= I_IN;
        if (r < I_OUT) { const int nblk = DMODEL / 32, kb = r / nblk, nb = r % nblk; p0_transpose_item(w_out, DMODEL, DMODEL, Wout, 64 * kb, 32 * nb, 32 * nb, scr, F.lane); continue; } r -= I_OUT;
        { const int g = r >> 5, q = r & 31, kb = q >> 3, nb = q & 7; p0_transpose_item(w_pool + (size_t)g * 65536, 256, 256, Wp + (size_t)g * 65536, 64 * kb, 32 * nb, 32 * nb, scr, F.lane); }
    }
    const float* x = a.in[0]; bf16* XN = (bf16*)(ws + WS_XN);
    for (int m = gw; m < MROWS; m += NGW) rms_row_to_bf16(x + (size_t)m * DMODEL, a.in[1], XN + (size_t)m * DMODEL, F.lane);
    float* rope = (float*)(ws + WS_ROPE);
    for (int e = (F.vcu * NWAVES * 64 + F.tid); e < SEQ * 32; e += F.G * NWAVES * 64) { const int pos = e >> 5, j = e & 31;
        const float angf = (float)pos * a.inv_freq[j]; const double ang = (double)angf;
        const double k = __builtin_rint(ang * 0.15915494309189535); const double r = (ang - k * 6.283185307179586) - k * 2.4492935982947064e-16; const double r2 = r * r;
        double ts = r, ss = r, tc = 1.0, cc = 1.0;
#pragma unroll
        for (int i = 1; i <= 13; ++i) { ts *= -r2 / (double)((2 * i) * (2 * i + 1)); ss += ts; tc *= -r2 / (double)((2 * i - 1) * (2 * i)); cc += tc; }
        rope[2 * e] = (float)cc; rope[2 * e + 1] = (float)ss; }
}
__global__ void __launch_bounds__(NWAVES * 64, 2) fwd_kernel(Args args) {
    extern __shared__ __attribute__((aligned(16))) unsigned char lds[];
    Frame F;
    F.lds = (LAS unsigned char*)lds; F.MISC = (volatile LAS unsigned*)(F.lds + MISC_OFF);
    F.tid = threadIdx.x; F.lane = F.tid & 63; F.wave = __builtin_amdgcn_readfirstlane(F.tid >> 6);
    F.G = gridDim.x; { const int bx = blockIdx.x; F.vcu = (F.G % 8 == 0) ? (bx % 8) * (F.G / 8) + bx / 8 : bx; }
    unsigned char* ws = args.ws; F.ctl = (gu32*)(ws + WS_CTL);
    for (int u = F.tid; u < (LDS_BYTES - LDSCTL_OFF) / 4; u += NWAVES * 64) ((LAS unsigned*)(F.lds + LDSCTL_OFF))[u] = 0u;
    __syncthreads();
    const int lo = args.ph_lo, hi = args.ph_hi; const bool use_bar = (hi - lo) > 1;
    XcdBarrier bar; bar.bar = (unsigned*)(F.ctl + CW_BAR); bar.x = 0; bar.st = nullptr;
    if (use_bar) bar = xcd_barrier_post((unsigned*)(F.ctl + CW_BAR), F.MISC + 8);
#define IN(k) (lo <= (k) && (k) < hi)
#define SEAM(k) do { if (IN(k) && IN((k) + 1)) xcd_barrier(bar); } while (0)
    bf16 *XN = (bf16*)(ws + WS_XN), *Ub = (bf16*)(ws + WS_U), *Qb = (bf16*)(ws + WS_Q), *Kb = (bf16*)(ws + WS_K), *Vb = (bf16*)(ws + WS_V), *MIX = (bf16*)(ws + WS_MIX), *ACT = (bf16*)(ws + WS_ACT);
    float *ssq1 = (float*)(ws + WS_SSQ1), *ssq2 = (float*)(ws + WS_SSQ2);

    if (IN(0)) { p0_prologue(F, args); SEAM(0); }

    if (IN(1)) {
        pg8::Gemm g{XN, (const bf16*)(ws + WS_WIN), MROWS, INW, DMODEL}; pg8::StaticOrder S; S.init(MROWS, INW, F.G, (int)blockIdx.x);
        pg8::EpiInProj E{Ub, Qb, ws + WS_K, (const float*)(ws + WS_ROPE)};
        pg8::gemm_phase<pg8::EpiInProj, pg8::StaticOrder, true, true>(F.lds + RING_OFF, g, S, E);
        SEAM(1);
    }

    if (IN(2)) {
        mix::lds_ptr shm = (mix::lds_ptr)(F.lds + RING_OFF);
        for (int u = F.vcu; u < 256; u += F.G) mix::pool_unit<0>(u >> 2, u & 3, Ub, (const bf16*)(ws + WS_WPOOL), args.in[4], MIX, shm);
        const float d1 = wave_sum(args.in[5][F.lane] * args.in[6][F.lane]), d2 = wave_sum(args.in[7][F.lane] * args.in[8][F.lane]);
        const float lam = expf(d1) - expf(d2) + 0.2f;
        for (int p = F.vcu; p < 256; p += F.G) { const int bh = p >> 3, s = p & 7;
            mix::attn_unit<0>(bh >> 3, bh & 7, s, Qb, ws + WS_K, MIX, args.in[9], lam, shm);
            mix::attn_unit<0>(bh >> 3, bh & 7, 15 - s, Qb, ws + WS_K, MIX, args.in[9], lam, shm); }
        SEAM(2);
    }

    if (IN(3)) {
        pg8::Gemm g{MIX, (const bf16*)(ws + WS_WOUT), MROWS, DMODEL, DMODEL}; pg8::StaticOrder S; S.init(MROWS, DMODEL, F.G, (int)blockIdx.x);
        pg8::EpiResSsq E{args.in[0], args.out, XN, args.in[11], ssq1};
        pg8::gemm_phase<pg8::EpiResSsq, pg8::StaticOrder, false, true>(F.lds + RING_OFF, g, S, E);
        SEAM(3);
    }

    if (IN(4)) {
        pg8::Gemm g{XN, (const bf16*)(ws + WS_WGU), MROWS, GUW, DMODEL}; pg8::StaticOrder S; S.init(MROWS, GUW, F.G, (int)blockIdx.x);
        pg8::EpiSwiGlu E{ACT, ssq1};
        pg8::gemm_phase<pg8::EpiSwiGlu, pg8::StaticOrder, true, true>(F.lds + RING_OFF, g, S, E);
        SEAM(4);
    }

    if (IN(5)) {
        pg8::Gemm g{ACT, (const bf16*)(ws + WS_WD), MROWS, DMODEL, FFN}; pg8::StaticOrder S; S.init(MROWS, DMODEL, F.G, (int)blockIdx.x);
        pg8::EpiResSsq E{args.out, args.out, nullptr, nullptr, ssq2};
        pg8::gemm_phase<pg8::EpiResSsq, pg8::StaticOrder, false, true>(F.lds + RING_OFF, g, S, E);
        SEAM(5);
    }

    if (IN(6)) {
        const int gw = F.vcu * NWAVES + F.wave, NGW = F.G * NWAVES;
        for (int m = gw; m < MROWS; m += NGW) final_norm_row(args.out + (size_t)m * DMODEL, ssq2 + (size_t)m * 8, args.in[14], F.lane);
    }
#ifdef PROBE_ATTN
    if (IN(7)) {
        mix::lds_ptr shm = (mix::lds_ptr)(F.lds + RING_OFF); bf16* MIX2 = (bf16*)(ws + WS_END);
        const float d1 = wave_sum(args.in[5][F.lane] * args.in[6][F.lane]), d2 = wave_sum(args.in[7][F.lane] * args.in[8][F.lane]);
        const float lam = expf(d1) - expf(d2) + 0.2f;
        for (int p = F.vcu; p < 256; p += F.G) { const int bh = p >> 3, s = p & 7;
            mix::attn_unit<PROBE_ATTN>(bh >> 3, bh & 7, s, Qb, ws + WS_K, MIX2, args.in[9], lam, shm);
            mix::attn_unit<PROBE_ATTN>(bh >> 3, bh & 7, 15 - s, Qb, ws + WS_K, MIX2, args.in[9], lam, shm); }
    }
#endif
#ifdef PROBE_EMPTY
    if (IN(7)) { if (F.tid == 99999) args.out[0] = 0.f; }
#endif
#ifdef PROBE_POOL
    if (IN(7)) { mix::lds_ptr shm = (mix::lds_ptr)(F.lds + RING_OFF); bf16* MIX2 = (bf16*)(ws + WS_END);
        for (int u = F.vcu; u < 256; u += F.G) mix::pool_unit<PROBE_POOL>(u >> 2, u & 3, Ub, (const bf16*)(ws + WS_WPOOL), args.in[4], MIX2, shm); }
#endif
#undef IN
#undef SEAM
}
#if DEBUG_CHECK
__device__ __forceinline__ float dbg_bf(bf16 v) { return __uint_as_float((unsigned)v << 16); }
__device__ __forceinline__ unsigned dbg_hash(unsigned x) { x ^= x >> 16; x *= 0x7feb352dU; x ^= x >> 15; x *= 0x846ca68bU; x ^= x >> 16; return x; }
__device__ __forceinline__ void dbg_rep(unsigned* ctl, int stage, float got, float exp, float a) {
    float e = fabsf(got - exp) / (fabsf(exp) + a); if (!(e == e) || !(e < 1e30f)) e = 1e30f;
    atomicMax(ctl + CW_ERR + stage, __float_as_uint(e));
}
__global__ void dbg_chk0(Args a) {
    unsigned* ctl = (unsigned*)(a.ws + WS_CTL); const int lane = threadIdx.x, i = blockIdx.x; unsigned char* ws = a.ws;
    { const int m = dbg_hash(i * 7 + 1) % MROWS; const float* xr = a.in[0] + (size_t)m * DMODEL; float s = 0.f;
      for (int k = lane; k < DMODEL; k += 64) s += xr[k] * xr[k];
      const float r = 1.0f / sqrtf(wave_sum(s) / DMODEL + NORM_EPS); const bf16* XN = (const bf16*)(ws + WS_XN);
      for (int k = lane; k < DMODEL; k += 64) dbg_rep(ctl, 0, dbg_bf(XN[(size_t)m * DMODEL + k]), xr[k] * r * a.in[1][k], 1e-3f); }
    { const int rho = dbg_hash(i * 7 + 2) % INW, k = (dbg_hash(i * 7 + 3) + 37 * lane) % DMODEL; const int pn = rho >> 8, c = rho & 255;
      const int n = (pn >= 4 && pn < 12) ? 256 * pn + 64 * ((c >> 5) & 3) + 32 * (c >> 7) + (c & 31) : rho;
      dbg_rep(ctl, 1, dbg_bf(((const bf16*)(ws + WS_WIN))[(size_t)rho * DMODEL + k]), a.in[2][(size_t)k * INW + n], 1e-4f); }
    { const int n = dbg_hash(i * 7 + 4) % DMODEL, k = (dbg_hash(i * 7 + 5) + 37 * lane) % DMODEL;
      dbg_rep(ctl, 2, dbg_bf(((const bf16*)(ws + WS_WOUT))[(size_t)n * DMODEL + k]), a.in[10][(size_t)k * DMODEL + n], 1e-4f); }
    { const int rho = dbg_hash(i * 7 + 6) % GUW, k = (dbg_hash(i * 7 + 8) + 37 * lane) % DMODEL; const int n = ((rho >> 7) & 1) * FFN + 128 * (rho >> 8) + (rho & 127);
      dbg_rep(ctl, 3, dbg_bf(((const bf16*)(ws + WS_WGU))[(size_t)rho * DMODEL + k]), a.in[12][(size_t)k * GUW + n], 1e-4f); }
    { const int n = dbg_hash(i * 7 + 9) % DMODEL, k = (dbg_hash(i * 7 + 10) + 37 * lane) % FFN;
      dbg_rep(ctl, 4, dbg_bf(((const bf16*)(ws + WS_WD))[(size_t)n * FFN + k]), a.in[13][(size_t)k * DMODEL + n], 1e-4f); }
    { const int g = i & 3, d = dbg_hash(i * 7 + 11) % 256, c = (dbg_hash(i * 7 + 12) + 37 * lane) % 256;
      dbg_rep(ctl, 5, dbg_bf(((const bf16*)(ws + WS_WPOOL))[(size_t)g * 65536 + d * 256 + c]), a.in[3][(size_t)g * 65536 + c * 256 + d], 1e-4f); }
}
__device__ __forceinline__ float dbg_dot_xn_w(const bf16* arow, const float* W, int K, int N, int n, int lane) {
    float s = 0.f; for (int k = lane; k < K; k += 64) s += dbg_bf(arow[k]) * W[(size_t)k * N + n]; return wave_sum(s);
}
__device__ __forceinline__ float dbg_k(const unsigned char* KV, int row, int c) {
    const int b = row >> 11, pos = row & 2047, h = c >> 7, comp = (c >> 6) & 1, d = c & 63;
    return dbg_bf(*(const bf16*)(KV + ((size_t)((b * 8 + h) * 32 + (pos >> 6)) << 15) + comp * 8192 + (d >> 3) * 1024 + (pos & 63) * 16 + (d & 7) * 2)); }
__device__ __forceinline__ float dbg_v(const unsigned char* KV, int row, int c) {
    const int b = row >> 11, pos = row & 2047, h = c >> 7, d = c & 127;
    return dbg_bf(*(const bf16*)(KV + ((size_t)((b * 8 + h) * 32 + (pos >> 6)) << 15) + 16384 + (d >> 5) * 4096 + (pos & 63) * 64 + (d & 31) * 2)); }
__global__ void dbg_chk1(Args a) {
    unsigned* ctl = (unsigned*)(a.ws + WS_CTL); const int lane = threadIdx.x, i = blockIdx.x; unsigned char* ws = a.ws;
    const int m = dbg_hash(i * 3 + 100) % MROWS; int c = dbg_hash(i * 3 + 101) % INW; if ((i & 3) == 0) c = 1024 + (c & 2047);
    const bf16* xr = (const bf16*)(ws + WS_XN) + (size_t)m * DMODEL; float exp_; float gotf;
    if (c < 1024) { exp_ = dbg_dot_xn_w(xr, a.in[2], DMODEL, INW, c, lane); gotf = dbg_bf(((const bf16*)(ws + WS_U))[(size_t)m * 1024 + c]); }
    else if (c >= 3072) { exp_ = dbg_dot_xn_w(xr, a.in[2], DMODEL, INW, c, lane); gotf = dbg_v(ws + WS_K, m, c - 3072); }
    else { const int j = c & 63, clo = (c & ~63) + (j & 31); const float x1 = dbg_dot_xn_w(xr, a.in[2], DMODEL, INW, clo, lane), x2 = dbg_dot_xn_w(xr, a.in[2], DMODEL, INW, clo + 32, lane);
        const float ang = (float)(m & 2047) * a.inv_freq[j & 31]; const double rev = (double)ang * 0.15915494309189535; const float fr = (float)(rev - __builtin_floor(rev));
        const float sn = __builtin_amdgcn_sinf(fr), cs = __builtin_amdgcn_cosf(fr);
        exp_ = (j < 32) ? x1 * cs - x2 * sn : x1 * sn + x2 * cs;
        if (c < 2048) { exp_ *= QSCALE; gotf = dbg_bf(((const bf16*)(ws + WS_Q))[(size_t)m * 1024 + c - 1024]); } else gotf = dbg_k(ws + WS_K, m, c - 2048); }
    if (lane == 0) dbg_rep(ctl, 6, gotf, exp_, 0.25f);
}
__global__ void dbg_chk2a(Args a) {
    unsigned* ctl = (unsigned*)(a.ws + WS_CTL); const int lane = threadIdx.x, i = blockIdx.x; unsigned char* ws = a.ws;
    int m = dbg_hash(i * 3 + 200) % MROWS; if ((i & 7) == 0) m = (m & ~2047) + (i >> 3) % 20; const int c = dbg_hash(i * 3 + 201) % 1024; const int g = c >> 8, d = c & 255, w = 2 << g, pos = m & 2047;
    const bf16* U = (const bf16*)(ws + WS_U); float s = 0.f;
    for (int cc = lane; cc < 256; cc += 64) { float ws_ = 0.f; int cnt = 0; for (int j = 0; j < w; ++j) if (pos - j >= 0) { ws_ += dbg_bf(U[(size_t)(m - j) * 1024 + g * 256 + cc]); ++cnt; }
        const float pooled = ws_ / (float)cnt - dbg_bf(U[(size_t)m * 1024 + g * 256 + cc]); s += pooled * a.in[3][(size_t)g * 65536 + cc * 256 + d]; }
    s = wave_sum(s) * a.in[4][c];
    if (lane == 0) dbg_rep(ctl, 7, dbg_bf(((const bf16*)(ws + WS_MIX))[(size_t)m * DMODEL + c]), s, 0.25f);
}
__global__ void dbg_chk2b(Args a) {
    __shared__ float sc[2][2048]; __shared__ float red[4]; __shared__ float od[128];
    unsigned* ctl = (unsigned*)(a.ws + WS_CTL); const int tid = threadIdx.x, lane = tid & 63, wv = tid >> 6, i = blockIdx.x; unsigned char* ws = a.ws;
    int m = dbg_hash(i * 3 + 300) % MROWS; if ((i & 3) == 0) m = (m & ~2047) + (dbg_hash(i) % 200); const int h = dbg_hash(i * 3 + 301) % 8; const int t = m & 2047, b = m >> 11;
    const int kend = ((t >> 6) + 1) * 64;
    const bf16 *Q = (const bf16*)(ws + WS_Q); const unsigned char* KV = ws + WS_K;
    const float d1 = wave_sum(a.in[5][lane] * a.in[6][lane]), d2 = wave_sum(a.in[7][lane] * a.in[8][lane]); const float lam = expf(d1) - expf(d2) + 0.2f;
    for (int k = tid; k < kend; k += 128) { float s1 = 0.f, s2 = 0.f; const bf16* qp = Q + (size_t)m * 1024 + h * 128;
        for (int d = 0; d < 64; ++d) { s1 += dbg_bf(qp[d]) * dbg_k(KV, b * 2048 + k, h * 128 + d); s2 += dbg_bf(qp[64 + d]) * dbg_k(KV, b * 2048 + k, h * 128 + 64 + d); }
        sc[0][k] = s1; sc[1][k] = s2; }
    __syncthreads();
    float mx[2], ll[2];
    for (int c = 0; c < 2; ++c) { float v = -1e30f; for (int k = tid; k < kend; k += 128) v = fmaxf(v, sc[c][k]);
        for (int o = 1; o < 64; o <<= 1) v = fmaxf(v, __shfl_xor(v, o)); if (lane == 0) red[wv] = v; __syncthreads(); mx[c] = fmaxf(red[0], red[1]); __syncthreads();
        float s = 0.f; for (int k = tid; k < kend; k += 128) s += exp2f(sc[c][k] - mx[c]); s = wave_sum(s); if (lane == 0) red[wv] = s; __syncthreads(); ll[c] = red[0] + red[1]; __syncthreads(); }
    float o = 0.f; const int d = tid;
    for (int k = 0; k < kend; ++k) { const float av = exp2f(sc[0][k] - mx[0]) / ll[0] - lam * exp2f(sc[1][k] - mx[1]) / ll[1]; o += av * dbg_v(KV, b * 2048 + k, h * 128 + d); }
    float ss = wave_sum(o * o); if (lane == 0) red[wv] = ss; __syncthreads(); ss = red[0] + red[1];
    const float exp_ = o / sqrtf(ss / 128.f + NORM_EPS) * a.in[9][d] * 0.8f;
    dbg_rep(ctl, 8, dbg_bf(((const bf16*)(ws + WS_MIX))[(size_t)m * DMODEL + 1024 + h * 128 + d]), exp_, 0.25f);
    (void)od;
}
__global__ void dbg_chk3(Args a) {
    unsigned* ctl = (unsigned*)(a.ws + WS_CTL); const int lane = threadIdx.x, i = blockIdx.x; unsigned char* ws = a.ws;
    const int m = dbg_hash(i * 3 + 400) % MROWS, n = dbg_hash(i * 3 + 401) % DMODEL;
    const float x1 = a.in[0][(size_t)m * DMODEL + n] + dbg_dot_xn_w((const bf16*)(ws + WS_MIX) + (size_t)m * DMODEL, a.in[10], DMODEL, DMODEL, n, lane);
    float s = 0.f; for (int k = lane; k < DMODEL; k += 64) { const float v = a.out[(size_t)m * DMODEL + k]; s += v * v; } s = wave_sum(s);
    const float* q = (const float*)(ws + WS_SSQ1) + (size_t)m * 8; float tot = 0.f; for (int j = 0; j < 8; ++j) tot += q[j];
    if (lane == 0) { dbg_rep(ctl, 9, a.out[(size_t)m * DMODEL + n], x1, 0.25f); dbg_rep(ctl, 10, dbg_bf(((const bf16*)(ws + WS_XN))[(size_t)m * DMODEL + n]), x1 * a.in[11][n], 0.25f); dbg_rep(ctl, 11, tot, s, 1.0f); }
}
__global__ void dbg_chk4(Args a) {
    unsigned* ctl = (unsigned*)(a.ws + WS_CTL); const int lane = threadIdx.x, i = blockIdx.x; unsigned char* ws = a.ws;
    const int m = dbg_hash(i * 3 + 500) % MROWS, j = dbg_hash(i * 3 + 501) % FFN;
    float s = 0.f; for (int k = lane; k < DMODEL; k += 64) { const float v = a.out[(size_t)m * DMODEL + k]; s += v * v; } const float r = 1.0f / sqrtf(wave_sum(s) / DMODEL + NORM_EPS);
    const bf16* xr = (const bf16*)(ws + WS_XN) + (size_t)m * DMODEL;
    const float g = r * dbg_dot_xn_w(xr, a.in[12], DMODEL, GUW, j, lane), up = r * dbg_dot_xn_w(xr, a.in[12], DMODEL, GUW, FFN + j, lane);
    if (lane == 0) dbg_rep(ctl, 12, dbg_bf(((const bf16*)(ws + WS_ACT))[(size_t)m * FFN + j]), g / (1.0f + expf(-g)) * up, 0.25f);
}
__global__ void dbg_chk5(Args a) {
    __shared__ float red[4];
    unsigned* ctl = (unsigned*)(a.ws + WS_CTL); const int tid = threadIdx.x, lane = tid & 63, wv = tid >> 6, i = blockIdx.x; unsigned char* ws = a.ws;
    const int m = dbg_hash(i * 3 + 600) % MROWS; float acc[8];
    const bf16* mr = (const bf16*)(ws + WS_MIX) + (size_t)m * DMODEL; const bf16* ar = (const bf16*)(ws + WS_ACT) + (size_t)m * FFN;
    for (int q = 0; q < 8; ++q) acc[q] = a.in[0][(size_t)m * DMODEL + tid + 256 * q];
    for (int k = 0; k < DMODEL; ++k) { const float v = dbg_bf(mr[k]); const float* wr = a.in[10] + (size_t)k * DMODEL + tid;
#pragma unroll
        for (int q = 0; q < 8; ++q) acc[q] += v * wr[256 * q]; }
    for (int k = 0; k < FFN; ++k) { const float v = dbg_bf(ar[k]); const float* wr = a.in[13] + (size_t)k * DMODEL + tid;
#pragma unroll
        for (int q = 0; q < 8; ++q) acc[q] += v * wr[256 * q]; }
    float s = 0.f;
#pragma unroll
    for (int q = 0; q < 8; ++q) s += acc[q] * acc[q];
    s = wave_sum(s); if (lane == 0) red[wv] = s; __syncthreads(); const float r = 1.0f / sqrtf((red[0] + red[1] + red[2] + red[3]) / DMODEL + NORM_EPS);
#pragma unroll
    for (int q = 0; q < 8; ++q) dbg_rep(ctl, 13, a.out[(size_t)m * DMODEL + tid + 256 * q], acc[q] * r * a.in[14][tid + 256 * q], 0.25f);
}
__global__ void dbg_report(Args a) {
    if (threadIdx.x != 0) return; const unsigned* ctl = (const unsigned*)(a.ws + WS_CTL);
    const float tol[14] = {0.006f, 0.005f, 0.005f, 0.005f, 0.005f, 0.005f, 0.03f, 0.03f, 0.05f, 0.03f, 0.03f, 0.001f, 0.05f, 0.03f};
    for (int s = 0; s < 14; ++s) { const float e = __uint_as_float(ctl[CW_ERR + s]); if (e > tol[s]) { a.out[0] = 1000.0f * (float)(s + 1); break; } }
    if (ctl[CW_BAR + XB_TMO] != 0u) a.out[1] = 77777.0f;
}
static void dbg_after_phase(int ph, const Args& a, hipStream_t st) {
    if (ph == 0) hipLaunchKernelGGL(dbg_chk0, dim3(256), dim3(64), 0, st, a);
    if (ph == 1) hipLaunchKernelGGL(dbg_chk1, dim3(2048), dim3(64), 0, st, a);
    if (ph == 2) { hipLaunchKernelGGL(dbg_chk2a, dim3(2048), dim3(64), 0, st, a); hipLaunchKernelGGL(dbg_chk2b, dim3(256), dim3(128), 0, st, a); }
    if (ph == 3) hipLaunchKernelGGL(dbg_chk3, dim3(2048), dim3(64), 0, st, a);
    if (ph == 4) hipLaunchKernelGGL(dbg_chk4, dim3(2048), dim3(64), 0, st, a);
    if (ph == 6) hipLaunchKernelGGL(dbg_chk5, dim3(32), dim3(256), 0, st, a);
}
#endif
extern "C" void kernel_launch(void* const* d_in, const int* in_sizes, int n_in, void* d_out, int out_size, void* d_ws, size_t ws_size, hipStream_t stream) {
    static int grid = 0;
    if (grid == 0) {
        if (n_in != 15 || in_sizes[0] != MROWS * DMODEL || out_size != MROWS * DMODEL || ws_size < WS_END) {
            fprintf(stderr, "kernel_launch: built for 15 inputs, x/out of %d floats, >= %zu bytes of workspace; got n_in %d, in0 %d, out %d, ws %zu; nothing launched\n", MROWS * DMODEL, (size_t)WS_END, n_in, n_in > 0 ? in_sizes[0] : -1, out_size, ws_size); grid = -1; return; }
        int dev = 0, cus = 0, per_cu = 0;
        if (hipGetDevice(&dev) != hipSuccess || hipDeviceGetAttribute(&cus, hipDeviceAttributeMultiprocessorCount, dev) != hipSuccess) { fprintf(stderr, "kernel_launch: device query failed\n"); grid = -1; return; }
        if (hipFuncSetAttribute((const void*)fwd_kernel, hipFuncAttributeMaxDynamicSharedMemorySize, LDS_BYTES) != hipSuccess) { fprintf(stderr, "kernel_launch: hipFuncSetAttribute failed\n"); grid = -1; return; }
        if (hipOccupancyMaxActiveBlocksPerMultiprocessor(&per_cu, (const void*)fwd_kernel, NWAVES * 64, LDS_BYTES) != hipSuccess) per_cu = 0;
        (void)hipGetLastError();
        if (per_cu < 1 || cus * (per_cu < 1 ? 1 : per_cu) < 256) { fprintf(stderr, "kernel_launch: needs 256 co-resident workgroups (CUs %d, per CU %d); nothing launched\n", cus, per_cu); grid = -1; return; }
        grid = 256;
    }
    if (grid < 0) return;
    (void)hipMemsetAsync((char*)d_ws + WS_CTL, 0, CTL_ZERO_BYTES, stream);
    Args a{};
    for (int i = 0; i < 15; ++i) a.in[i] = (const float*)d_in[i];
    a.out = (float*)d_out; a.ws = (unsigned char*)d_ws;
    for (int j = 0; j < 32; ++j) a.inv_freq[j] = powf(10000.0f, -(float)(2 * j) / 64.0f);
#if DEBUG_CHECK
    for (int ph = 0; ph < N_PHASES; ++ph) { a.ph_lo = ph; a.ph_hi = ph + 1; hipLaunchKernelGGL(fwd_kernel, dim3(grid), dim3(NWAVES * 64), LDS_BYTES, stream, a); dbg_after_phase(ph, a, stream); }
    hipLaunchKernelGGL(dbg_report, dim3(1), dim3(64), 0, stream, a);
#else
    constexpr int NL = MK_N_LAUNCHES;
    for (int li = 0; li < NL; ++li) { a.ph_lo = (NL == 1) ? 0 : li; a.ph_hi = (NL == 1) ? N_PHASES : li + 1; hipLaunchKernelGGL(fwd_kernel, dim3(grid), dim3(NWAVES * 64), LDS_BYTES, stream, a);
#if defined(PROBE_ATTN) || defined(PROBE_POOL) || defined(PROBE_EMPTY)
        if (NL > 1 && li == 2) { Args b2 = a; b2.ph_lo = 7; b2.ph_hi = 8; hipLaunchKernelGGL(fwd_kernel, dim3(grid), dim3(NWAVES * 64), LDS_BYTES, stream, b2); }
#endif
#ifdef PROBE_DUP
        if (NL > 1 && li == PROBE_DUP) hipLaunchKernelGGL(fwd_kernel, dim3(grid), dim3(NWAVES * 64), LDS_BYTES, stream, a);
#endif
    }
#endif
    const hipError_t le = hipPeekAtLastError();
    if (le != hipSuccess) fprintf(stderr, "kernel_launch: launch failed: %s\n", hipGetErrorName(le));
}
```
